# Optimizing an MI355X kernel written in HIP

```python
import math
import jax, jax.numpy as jnp
from jax import lax
import numpy as np

D_MODEL = 1024
BATCH = 4
SEQ = 8192
DEPTH = 2
DEC_BATCH = 16
DEC_SEQ = 16
PAST_LEN = 4096

CHUNK = 64
N_META = 16
N_MIXERS = 2
N_LAYERS_A = (DEPTH + N_MIXERS - 1) // N_MIXERS
N_LAYERS_B = DEPTH // N_MIXERS
HG_HEADS = 8
HG_DK = 128
HG_DV = D_MODEL // HG_HEADS
HG_DIM = HG_HEADS * HG_DK
HG_VDIM = HG_HEADS * HG_DV
GLA_BLOCK = 16
D_RNN = D_MODEL
RG_BLOCKS = 8
RG_BW = D_RNN // RG_BLOCKS
CONV_W = 4
RG_C = 8.0
D_FF = 2816
FFN_RES = 0.5
EPS = 1e-6

kernel_name = 'hgrn2_rglru_macaron_stream_step'


def rmsnorm(x, g):
    xf = x.astype(jnp.float32)
    y = xf * lax.rsqrt(jnp.mean(xf * xf, axis=-1, keepdims=True) + EPS)
    return (y * g.astype(jnp.float32)).astype(x.dtype)


def swiglu_half(x, g, w_in, w_out):
    a, b = jnp.split(rmsnorm(x, g) @ w_in, 2, axis=-1)
    return (jax.nn.silu(a) * b) @ w_out


def gla_blocked(q, k, v, logf, s0, block):
    B, T, H, DK = q.shape
    DV = v.shape[-1]
    n = T // block

    def to_blocks(t):
        return t.reshape(B, n, block, H, t.shape[-1]).transpose(1, 0, 3, 2, 4)

    mask = jnp.tril(jnp.ones((block, block), dtype=bool))

    def step(S, inp):
        qc, kc, vc, gc = inp
        b = jnp.cumsum(gc, axis=-2)
        b_last = b[:, :, -1:, :]
        q_d = qc * jnp.exp(b)
        k_d = kc * jnp.exp(-b)
        scores = jnp.where(mask, jnp.einsum('bhtk,bhsk->bhts', q_d, k_d), 0.0)
        o = (jnp.einsum('bhts,bhsv->bhtv', scores, vc)
             + jnp.einsum('bhtk,bhkv->bhtv', q_d, S))
        S_new = (jnp.exp(b_last[:, :, 0, :])[..., None] * S
                 + jnp.einsum('bhsk,bhsv->bhkv', kc * jnp.exp(b_last - b), vc))
        return S_new, o

    S, o = lax.scan(step, s0.astype(jnp.float32),
                    (to_blocks(q), to_blocks(k), to_blocks(v), to_blocks(logf)))
    o = o.transpose(1, 0, 3, 2, 4).reshape(B, T, H, DV)
    return o, S


def hgrn2_mixer(x, s0, w_in, lb, onorm, w_out):
    B, T, _ = x.shape
    proj = (x @ w_in).astype(jnp.float32)
    q, fr, i, g = jnp.split(proj, [HG_DIM, 2 * HG_DIM, 2 * HG_DIM + HG_VDIM], axis=-1)
    f = lb + (1.0 - lb) * jax.nn.sigmoid(fr)
    logf = jnp.log(f)
    k = 1.0 - f
    q = jax.nn.silu(q)
    o, S = gla_blocked(q.reshape(B, T, HG_HEADS, HG_DK), k.reshape(B, T, HG_HEADS, HG_DK),
                       i.reshape(B, T, HG_HEADS, HG_DV), logf.reshape(B, T, HG_HEADS, HG_DK),
                       s0, math.gcd(T, GLA_BLOCK))
    o = o * lax.rsqrt(jnp.mean(o * o, axis=-1, keepdims=True) + EPS)
    o = o * onorm.astype(jnp.float32).reshape(HG_HEADS, HG_DV)
    o = o.reshape(B, T, HG_VDIM) * jax.nn.silu(g)
    return o.astype(x.dtype) @ w_out, S


def _lin_combine(left, right):
    a1, b1 = left
    a2, b2 = right
    return a1 * a2, a2 * b1 + b2


def rglru_mixer(x, h0, conv0, w_in, conv_w, conv_b, wa, ba, wx, bx, lam, w_out):
    B, T, _ = x.shape
    xb, gb = jnp.split(x @ w_in, 2, axis=-1)
    xpad = jnp.concatenate([conv0.astype(xb.dtype), xb], axis=1)
    conv = conv_b + xpad[:, 0:T] * conv_w[0]
    for j in range(1, CONV_W):
        conv = conv + xpad[:, j:j + T] * conv_w[j]
    new_conv = xpad[:, T:]
    cf = conv.astype(jnp.float32)
    cb = cf.reshape(B, T, RG_BLOCKS, RG_BW)
    r = jax.nn.sigmoid(jnp.einsum('btnc,ncd->btnd', cb, wa.astype(jnp.float32)).reshape(B, T, D_RNN) + ba)
    ig = jax.nn.sigmoid(jnp.einsum('btnc,ncd->btnd', cb, wx.astype(jnp.float32)).reshape(B, T, D_RNN) + bx)
    log_a = -RG_C * r * jax.nn.softplus(-lam.astype(jnp.float32))
    a = jnp.exp(log_a)
    u = jnp.sqrt(-jnp.expm1(2.0 * log_a)) * (ig * cf)
    a_cum, b_cum = lax.associative_scan(_lin_combine, (a, u), axis=1)
    h = a_cum * h0.astype(jnp.float32)[:, None, :] + b_cum
    y = (h * jax.nn.gelu(gb.astype(jnp.float32))).astype(x.dtype)
    return y @ w_out, h[:, -1], new_conv


def run_trunk(h, s_hgrn, s_h, s_conv, ffn_norm, ffn_w_in, ffn_w_out, mix_norm,
              a_w_in, a_lb, a_onorm, a_w_out, b_w_in, b_conv_w, b_conv_b,
              b_wa, b_ba, b_wx, b_bx, b_lambda, b_w_out):
    lb_all = jnp.cumsum(jax.nn.softmax(a_lb.astype(jnp.float32), axis=0), axis=0)
    new_S, new_h, new_c = [], [], []
    for layer in range(DEPTH):
        h = h + FFN_RES * swiglu_half(h, ffn_norm[layer, 0], ffn_w_in[layer, 0], ffn_w_out[layer, 0])
        hn = rmsnorm(h, mix_norm[layer])
        j = layer // N_MIXERS
        if layer % N_MIXERS == 0:
            out, S = hgrn2_mixer(hn, s_hgrn[j], a_w_in[j], lb_all[j], a_onorm[j], a_w_out[j])
            new_S.append(S)
        else:
            out, hl, cv = rglru_mixer(hn, s_h[j], s_conv[j], b_w_in[j], b_conv_w[j], b_conv_b[j],
                                      b_wa[j], b_ba[j], b_wx[j], b_bx[j], b_lambda[j], b_w_out[j])
            new_h.append(hl)
            new_c.append(cv)
        h = h + out
        h = h + FFN_RES * swiglu_half(h, ffn_norm[layer, 1], ffn_w_in[layer, 1], ffn_w_out[layer, 1])
    return h, jnp.stack(new_S), jnp.stack(new_h), jnp.stack(new_c)


def setup_inputs(seed: int = 0) -> dict:
    key = jax.random.key(seed)
    ks = jax.random.split(key, 24)
    f32 = jnp.float32

    def nrm(k, shape, scale):
        return jax.random.normal(k, shape, f32) * scale

    u = jax.random.uniform(ks[21], (N_LAYERS_B, D_RNN), f32, 0.9, 0.999)
    s = u ** (1.0 / RG_C)
    lam = jnp.log(s) - jnp.log1p(-s)
    return {
        'x_prompt': nrm(ks[0], (BATCH, SEQ, D_MODEL), 1.0),
        'x_sample': nrm(ks[1], (DEC_BATCH, DEC_SEQ, D_MODEL), 1.0),
        'state_hgrn': nrm(ks[2], (N_LAYERS_A, DEC_BATCH, HG_HEADS, HG_DK, HG_DV), 0.5),
        'state_rglru': nrm(ks[3], (N_LAYERS_B, DEC_BATCH, D_RNN), 0.5),
        'state_conv': nrm(ks[4], (N_LAYERS_B, DEC_BATCH, CONV_W - 1, D_RNN), 1.0),
        'meta_tokens': nrm(ks[5], (N_META, D_MODEL), 1.0),
        'ffn_norm': 1.0 + nrm(ks[6], (DEPTH, 2, D_MODEL), 0.05),
        'ffn_w_in': nrm(ks[7], (DEPTH, 2, D_MODEL, 2 * D_FF), D_MODEL ** -0.5),
        'ffn_w_out': nrm(ks[8], (DEPTH, 2, D_FF, D_MODEL), D_FF ** -0.5),
        'mix_norm': 1.0 + nrm(ks[9], (DEPTH, D_MODEL), 0.05),
        'a_w_in': nrm(ks[10], (N_LAYERS_A, D_MODEL, 2 * HG_DIM + 2 * HG_VDIM), D_MODEL ** -0.5),
        'a_lb': nrm(ks[11], (N_LAYERS_A + 1, HG_DIM), 0.5),
        'a_onorm': 1.0 + nrm(ks[12], (N_LAYERS_A, HG_VDIM), 0.05),
        'a_w_out': nrm(ks[13], (N_LAYERS_A, HG_VDIM, D_MODEL), HG_VDIM ** -0.5),
        'b_w_in': nrm(ks[14], (N_LAYERS_B, D_MODEL, 2 * D_RNN), D_MODEL ** -0.5),
        'b_conv_w': nrm(ks[15], (N_LAYERS_B, CONV_W, D_RNN), CONV_W ** -0.5),
        'b_conv_b': nrm(ks[16], (N_LAYERS_B, D_RNN), 0.02),
        'b_wa': nrm(ks[17], (N_LAYERS_B, RG_BLOCKS, RG_BW, RG_BW), RG_BW ** -0.5),
        'b_ba': nrm(ks[18], (N_LAYERS_B, D_RNN), 0.02),
        'b_wx': nrm(ks[19], (N_LAYERS_B, RG_BLOCKS, RG_BW, RG_BW), RG_BW ** -0.5),
        'b_bx': nrm(ks[20], (N_LAYERS_B, D_RNN), 0.02),
        'b_lambda': lam,
        'b_w_out': nrm(ks[22], (N_LAYERS_B, D_RNN, D_MODEL), D_RNN ** -0.5),
        'final_norm': 1.0 + nrm(ks[23], (D_MODEL,), 0.05),
    }


def reference(x_prompt, x_sample, state_hgrn, state_rglru, state_conv, meta_tokens,
              ffn_norm, ffn_w_in, ffn_w_out, mix_norm, a_w_in, a_lb, a_onorm, a_w_out,
              b_w_in, b_conv_w, b_conv_b, b_wa, b_ba, b_wx, b_bx, b_lambda, b_w_out, final_norm):
    dt = x_prompt.dtype
    B = x_prompt.shape[0]
    meta = jnp.broadcast_to(meta_tokens.astype(dt)[None], (B, N_META, D_MODEL))
    xp = jnp.concatenate([meta, x_prompt], axis=1)
    zS = jnp.zeros((N_LAYERS_A, B, HG_HEADS, HG_DK, HG_DV), jnp.float32)
    zh = jnp.zeros((N_LAYERS_B, B, D_RNN), jnp.float32)
    zc = jnp.zeros((N_LAYERS_B, B, CONV_W - 1, D_RNN), dt)
    hp, hgrn_p, rglru_p, conv_p = run_trunk(
        xp, zS, zh, zc, ffn_norm, ffn_w_in, ffn_w_out, mix_norm, a_w_in, a_lb, a_onorm, a_w_out,
        b_w_in, b_conv_w, b_conv_b, b_wa, b_ba, b_wx, b_bx, b_lambda, b_w_out)
    y_prompt = rmsnorm(hp[:, N_META:], final_norm)
    hs, hgrn_s, rglru_s, conv_s = run_trunk(
        x_sample, state_hgrn, state_rglru, state_conv, ffn_norm, ffn_w_in, ffn_w_out, mix_norm,
        a_w_in, a_lb, a_onorm, a_w_out, b_w_in, b_conv_w, b_conv_b, b_wa, b_ba, b_wx, b_bx,
        b_lambda, b_w_out)
    y_sample = rmsnorm(hs, final_norm)
    return (y_prompt, y_sample, hgrn_p, hgrn_s, rglru_p, rglru_s, conv_p, conv_s)
```

```cpp
#include <hip/hip_runtime.h>
#include <hip/hip_cooperative_groups.h>
#include <cstdio>
#include <cstddef>
namespace cg = cooperative_groups;

#ifndef PHASE_MASK
#define PHASE_MASK 0x1FFFFF
#endif
#ifndef MK_FUSED
#define MK_FUSED 1
#endif

#define LAS __attribute__((address_space(3)))
typedef unsigned short bf16_t;
typedef short bf16x8 __attribute__((ext_vector_type(8)));
typedef float f32x4 __attribute__((ext_vector_type(4)));
typedef float f32x2 __attribute__((ext_vector_type(2)));
typedef unsigned u32x4 __attribute__((ext_vector_type(4)));
typedef unsigned u32x2 __attribute__((ext_vector_type(2)));

constexpr int D = 1024, DFF = 2816, NTHR = 512;
constexpr int MP = 33280;
constexpr int ROW_SAMPLE = 32768;
constexpr int ROW_META = 33024;
constexpr int ROW_PAD = 33088;
constexpr int NCH = 33;
constexpr int RCH = 129;
constexpr float EPS = 1e-6f;

constexpr size_t O_YP = 0, O_YS = 33554432, O_HP = 33816576, O_HS = O_HP + 524288, O_RP = O_HS + 2097152, O_RS = O_RP + 4096,
                 O_CP = O_RS + 16384, O_CS = O_CP + 12288;
constexpr size_t SZ_ACT = (size_t)MP * D * 2;
constexpr size_t W_FFN_IN = 0, SZ_FFN_IN = (size_t)2 * DFF * D * 2;
constexpr size_t W_FFN_OUT = W_FFN_IN + 4 * SZ_FFN_IN, SZ_FFN_OUT = (size_t)D * DFF * 2;
constexpr size_t W_A_IN = W_FFN_OUT + 4 * SZ_FFN_OUT;
constexpr size_t W_A_OUT = W_A_IN + (size_t)4096 * D * 2;
constexpr size_t W_B_IN = W_A_OUT + (size_t)D * D * 2;
constexpr size_t W_B_OUT = W_B_IN + (size_t)2048 * D * 2;
constexpr size_t W_G = W_B_OUT + (size_t)D * D * 2;
constexpr size_t WS_VEC = W_G + (size_t)8 * 256 * 256 * 2;
constexpr size_t WS_HB = WS_VEC + 8192;
constexpr size_t WS_PART = WS_HB + SZ_ACT, SZ_PART = (size_t)MP * 16 * 4;
constexpr size_t WS_HTAIL = WS_PART + 2 * SZ_PART;
constexpr size_t WS_SCR = WS_HTAIL + (size_t)256 * D * 4;
constexpr size_t SC_U = WS_SCR;
constexpr size_t SC_Q = WS_SCR, SC_K = SC_Q + SZ_ACT, SC_V = SC_K + SZ_ACT, SC_G = SC_V + SZ_ACT, SC_SST = SC_G + SZ_ACT,
                 SC_DC = SC_SST + (size_t)4 * 8 * NCH * 16384 * 4, SC_END1 = SC_DC + (size_t)4 * 8 * NCH * 128 * 4;
constexpr size_t SC_XB = WS_SCR, SC_GG = SC_XB + SZ_ACT, SC_CF = SC_GG + SZ_ACT, SC_OM = SC_CF + SZ_ACT, SC_UU = SC_OM + SZ_ACT,
                 SC_AB = SC_UU + SZ_ACT, SC_END2 = SC_AB + (size_t)4 * RCH * 1024 * 2 * 4;
constexpr size_t WS_END = (SC_END1 > SC_END2 ? SC_END1 : SC_END2);
static_assert((size_t)MP * DFF * 2 <= SC_END1 - WS_SCR, "U fits");
constexpr size_t WS_BAR = (WS_END + 255) / 256 * 256, WS_ZERO = WS_BAR + 16384, WS_TOTAL = WS_ZERO + 65536;
static_assert(WS_TOTAL <= (size_t)536870912, "workspace budget");

struct Params {
    const float *x_prompt, *x_sample, *state_hgrn, *state_rglru, *state_conv, *meta, *ffn_norm, *ffn_w_in, *ffn_w_out, *mix_norm,
        *a_w_in, *a_lb, *a_onorm, *a_w_out, *b_w_in, *b_conv_w, *b_conv_b, *b_wa, *b_ba, *b_wx, *b_bx, *b_lambda, *b_w_out, *final_norm;
    float* out; unsigned char* ws; int ph_lo, ph_hi;
};

typedef __bf16 bf16x2v_ __attribute__((ext_vector_type(2)));
__device__ __forceinline__ unsigned cvt_pk_bf16(float lo, float hi) { const f32x2 v = {lo, hi}; return __builtin_bit_cast(unsigned, __builtin_convertvector(v, bf16x2v_)); }
__device__ __forceinline__ float bf_lo(unsigned w) { return __uint_as_float(w << 16); }
__device__ __forceinline__ float bf_hi(unsigned w) { return __uint_as_float(w & 0xffff0000u); }
__device__ __forceinline__ float bf2f(bf16_t b) { return __uint_as_float(((unsigned)b) << 16); }
__device__ __forceinline__ float sigmoidf_(float x) { return __builtin_amdgcn_rcpf(1.0f + __expf(-x)); }
__device__ __forceinline__ float siluf_(float x) { return x * sigmoidf_(x); }
__device__ __forceinline__ float gelu_tanh(float x) { const float t = 1.5957691216f * (x + 0.044715f * x * x * x); return x * sigmoidf_(t); }
__device__ __forceinline__ float* hrow(float* hmain, float* htail, int row) { return row < ROW_META ? hmain + (size_t)row * D : htail + (size_t)(row - ROW_META) * D; }
#define GASP __attribute__((address_space(1)))
__device__ __forceinline__ void gst16(void* p, u32x4 v) { *(GASP u32x4*)(GASP void*)p = v; }
__device__ __forceinline__ void gst8u(void* p, u32x2 v) { *(GASP u32x2*)(GASP void*)p = v; }
__device__ __forceinline__ void gst16f(void* p, f32x4 v) { *(GASP f32x4*)(GASP void*)p = v; }
__device__ __forceinline__ f32x4 gld16f(const void* p) { return *(const GASP f32x4*)(const GASP void*)p; }
__device__ __forceinline__ float* hrow2(float* hmain, float* htail, int row) {
    const long long d = (long long)((const char*)htail - (const char*)hmain) - (long long)ROW_META * D * 4;
    return (float*)((char*)hmain + (size_t)row * D * 4 + (row >= ROW_META ? d : 0ll)); }

__device__ __forceinline__ unsigned long long karg(int i) { const __attribute__((address_space(4))) unsigned long long* ka = (const __attribute__((address_space(4))) unsigned long long*)__builtin_amdgcn_kernarg_segment_ptr(); asm volatile("" : "+s"(ka)); return ka[i]; }
#define LP(f) ((decltype(Params::f))karg((int)(offsetof(Params, f) / 8)))
#define LOADP(f) p.f = LP(f)
__device__ __forceinline__ float shx(float v, int o, int lane) { return __int_as_float(__builtin_amdgcn_ds_bpermute((lane ^ o) << 2, __float_as_int(v))); }
__device__ __forceinline__ int otid() { int t = threadIdx.x; asm volatile("" : "+v"(t)); return t; }
__device__ __forceinline__ int obid() { int b = blockIdx.x; asm volatile("" : "+s"(b)); return b; }
namespace pg8 {
constexpr int BM = 256, BK = 64, HALF = 128, HTB = HALF * BK * 2, STAGE_BYTES = 8 * HTB, NXCD = 8, WGM = 8;
__host__ __device__ __forceinline__ int lds_byte(int r, int c) { const int st = (r >> 4) * 2 + (c >> 5), rr = r & 15, cc = c & 31, ob = rr * 64 + cc * 2; return st * 1024 + (ob ^ (((ob >> 9) & 1) << 5)); }
__host__ __device__ __forceinline__ void stage_rc(int b, int& R, int& C) { const int st = b / 1024, sb = b % 1024, swz = sb ^ (((sb >> 9) & 1) << 5); R = (st >> 1) * 16 + swz / 64; C = (st & 1) * 32 + (swz % 64) / 2; }
__host__ __device__ __forceinline__ int perm32(int rho) { const int n = rho >> 4, i = rho & 15; return 8 * (i >> 2) + 4 * n + (i & 3); }
struct Unit { int pm, pn; };
struct Gemm { const bf16_t* A; const bf16_t* Bt; int lda, ldb, K, nM, nN; };
struct StaticOrder {
    int nM, nN, nwg, G, c, mode, spm, spn;
    __device__ void init(int nM_, int nN_, int G_, int c_) { nM = nM_; nN = nN_; nwg = nM * nN; G = G_; c = c_; mode = 0; spm = 0; spn = 0; }
    __device__ bool next(int i, Unit& u) const {
        if (mode == 2) { if (i > 0) return false; u.pm = spm; u.pn = spn; return true; }
        long L;
        if (mode == 1) {
            if (c >= 248) { if (i >= 9) return false; L = (long)i * 256 + c; }
            else if (c >= 44 && c < 60) { if (i < 11) L = (long)i * 256 + c; else if (i == 11) L = 2304 + 256 * ((c - 44) >> 3) + 248 + ((c - 44) & 7); else return false; }
            else { L = (long)i * 256 + c; if (L >= 2860) return false; }
            if (L < 44) { u.pm = 128 + ((int)L & 1); u.pn = (int)L >> 1; return true; }
            L -= 44;
            int wgid = (int)L; { const int q = 2816 / NXCD, xcd = wgid % NXCD, off = wgid / NXCD; wgid = xcd * q + off; }
            const int nig = WGM * 22, gid = wgid / nig; u.pm = gid * WGM + ((wgid % nig) % WGM); u.pn = (wgid % nig) / WGM; return true;
        }
        L = (long)i * G + c; if (L >= nwg) return false;
        int wgid = (int)L; { const int q = nwg / NXCD, r = nwg % NXCD, xcd = wgid % NXCD, off = wgid / NXCD; wgid = (xcd < r ? xcd * (q + 1) : r * (q + 1) + (xcd - r) * q) + off; }
        const int nig = WGM * nN, gid = wgid / nig, fm = gid * WGM, gsz = (nM - fm) < WGM ? (nM - fm) : WGM;
        u.pm = fm + ((wgid % nig) % gsz); u.pn = (wgid % nig) / gsz; return true;
    }
};

template <class Epi, bool AKOFF>
__device__ __forceinline__ void gemm_phase(LAS unsigned char* lds, const Gemm g, const StaticOrder& S, const Epi& E) {
    int tid_ = otid();
    const int tid = tid_, wid = __builtin_amdgcn_readfirstlane(tid >> 6), lane = tid & 63, wr = wid >> 2, wc = wid & 3, fr = lane & 15, fq = lane >> 4;
    const int K = g.K, nt = K / BK;
    unsigned voffA[2], voffB[2];
#pragma unroll
    for (int i = 0; i < 2; ++i) { int R, C; stage_rc(tid * 16 + i * 8192, R, C); const int Rb = Epi::PERM ? ((R & ~31) + perm32(R & 31)) : R;
        voffA[i] = (unsigned)(R * g.lda + C) * 2u; voffB[i] = (unsigned)(Rb * g.ldb + C) * 2u; }
    const size_t kstep = (size_t)(BK * 2);
    const size_t hstepA = (size_t)HALF * g.lda * 2, hstepB = (size_t)HALF * g.ldb * 2;
    const unsigned ldsw = (unsigned)wid * 1024u;
    const int aoff = lds_byte(wr * 64 + fr, fq * 8), boff = lds_byte(wc * 32 + fr, fq * 8);
#define PG8_SA(b, h) (((b) * 2 + (h)) * HTB)
#define PG8_SB(b, h) ((4 + (b) * 2 + (h)) * HTB)
#define PG8_STAGE(bufoff, gbase, voff) do { _Pragma("unroll") for (int _i = 0; _i < 2; ++_i) \
        __builtin_amdgcn_global_load_lds((const unsigned*)((const char*)(gbase) + (voff)[_i]), (LAS unsigned*)(lds + (bufoff) + ldsw + _i * 8192), 16, 0, 0); } while (0)
#define PG8_LDA(dst, b, h) do { _Pragma("unroll") for (int m = 0; m < 4; ++m) _Pragma("unroll") for (int k = 0; k < 2; ++k) dst[m][k] = *(const LAS bf16x8*)(lds + PG8_SA(b, h) + aoff + m * 2048 + k * 1024); } while (0)
#define PG8_LDB(dst, b, h) do { _Pragma("unroll") for (int n = 0; n < 2; ++n) _Pragma("unroll") for (int k = 0; k < 2; ++k) dst[n][k] = *(const LAS bf16x8*)(lds + PG8_SB(b, h) + boff + n * 2048 + k * 1024); } while (0)
#define PG8_MMA(ai, bj, At, Bt) do { __builtin_amdgcn_s_setprio(1); _Pragma("unroll") for (int m = 0; m < 4; ++m) _Pragma("unroll") for (int n = 0; n < 2; ++n) _Pragma("unroll") for (int k = 0; k < 2; ++k) \
        acc[ai][bj][m][n] = __builtin_amdgcn_mfma_f32_16x16x32_bf16(Bt[n][k], At[m][k], acc[ai][bj][m][n], 0, 0, 0); __builtin_amdgcn_s_setprio(0); } while (0)
#define PG8_WAIT_V(n) asm volatile("s_waitcnt vmcnt(" #n ")" ::: "memory")
#define PG8_WAIT_L(n) asm volatile("s_waitcnt lgkmcnt(" #n ")" ::: "memory")
#define PG8_BAR __builtin_amdgcn_s_barrier()
#define PG8_SCHED __builtin_amdgcn_sched_barrier(0)
#define PG8_UA(u) ((const char*)g.A + ((size_t)(u).pm * BM * g.lda + (AKOFF ? (size_t)128 * (u).pn : (size_t)0)) * 2)
#define PG8_UB(u) ((const char*)g.Bt + (size_t)(u).pn * BM * g.ldb * 2)
    Unit cur, nxt; int ui = 0;
    if (!S.next(0, cur)) return;
    f32x4 acc[2][2][4][2];
#pragma unroll
    for (int a = 0; a < 2; ++a)
#pragma unroll
        for (int b = 0; b < 2; ++b)
#pragma unroll
            for (int m = 0; m < 4; ++m)
#pragma unroll
                for (int n = 0; n < 2; ++n) acc[a][b][m][n] = (f32x4){0.f, 0.f, 0.f, 0.f};
    bf16x8 At[4][2], B0[2][2], B1[2][2];
    const char* cA = PG8_UA(cur); const char* cB = PG8_UB(cur);
    PG8_STAGE(PG8_SB(0, 0), cB, voffB); PG8_STAGE(PG8_SA(0, 0), cA, voffA); PG8_STAGE(PG8_SB(0, 1), cB + hstepB, voffB); PG8_STAGE(PG8_SA(0, 1), cA + hstepA, voffA);
    if (wr == 1) PG8_BAR;
    PG8_WAIT_V(4); PG8_BAR;
    PG8_STAGE(PG8_SB(1, 0), cB + kstep, voffB); PG8_STAGE(PG8_SA(1, 0), cA + kstep, voffA); PG8_STAGE(PG8_SB(1, 1), cB + hstepB + kstep, voffB);
    PG8_WAIT_V(6); PG8_BAR;
    for (;;) {
        if (Epi::PARTPF) {
            if (ui > 0) { PG8_BAR; PG8_BAR; }
            unsigned pvo = (unsigned)(tid & 63) * 16u + (unsigned)wid * 2048u; asm volatile("" : "+v"(pvo));
            const char* psrc = (const char*)E.part + (size_t)cur.pm * (256 * 64);
            _Pragma("unroll") for (int _i = 0; _i < 2; ++_i)
                __builtin_amdgcn_global_load_lds((const unsigned*)(psrc + pvo + _i * 1024), (LAS unsigned*)(lds + STAGE_BYTES + wid * 2048 + _i * 1024), 16, 0, 0);
        }
        const bool has_next = S.next(ui + 1, nxt);
        const char* nA = has_next ? PG8_UA(nxt) : cA; const char* nB = has_next ? PG8_UB(nxt) : cB;
        for (int t = 0; t < nt; t += 2) {
            const bool last = (t == nt - 2);
            const char* a1 = cA + (size_t)(t + 1) * kstep;
            const char* a2 = last ? nA : cA + (size_t)(t + 2) * kstep; const char* b2 = last ? nB : cB + (size_t)(t + 2) * kstep;
            const char* a3 = a2 + kstep; const char* b3 = b2 + kstep;
            PG8_LDB(B0, 0, 0); PG8_SCHED; PG8_LDA(At, 0, 0); PG8_STAGE(PG8_SA(1, 1), a1 + hstepA, voffA);
            PG8_WAIT_L(8); PG8_BAR; PG8_WAIT_L(0); PG8_MMA(0, 0, At, B0); PG8_BAR; PG8_SCHED;
            PG8_LDB(B1, 0, 1); PG8_STAGE(PG8_SB(0, 0), b2, voffB);
            PG8_BAR; PG8_WAIT_L(0); PG8_MMA(0, 1, At, B1); PG8_BAR;
            PG8_LDA(At, 0, 1); PG8_STAGE(PG8_SA(0, 0), a2, voffA);
            PG8_BAR; PG8_WAIT_L(0); PG8_MMA(1, 0, At, B0); PG8_BAR; PG8_SCHED;
            PG8_STAGE(PG8_SB(0, 1), b2 + hstepB, voffB);
            PG8_WAIT_V(6); PG8_BAR; PG8_MMA(1, 1, At, B1); PG8_BAR;
            PG8_LDB(B0, 1, 0); PG8_SCHED; PG8_LDA(At, 1, 0); PG8_STAGE(PG8_SA(0, 1), a2 + hstepA, voffA);
            PG8_WAIT_L(8); PG8_BAR; PG8_WAIT_L(0); PG8_MMA(0, 0, At, B0); PG8_BAR; PG8_SCHED;
            PG8_LDB(B1, 1, 1); PG8_STAGE(PG8_SB(1, 0), b3, voffB);
            PG8_BAR; PG8_WAIT_L(0); PG8_MMA(0, 1, At, B1); PG8_BAR;
            PG8_LDA(At, 1, 1); PG8_STAGE(PG8_SA(1, 0), a3, voffA);
            PG8_BAR; PG8_WAIT_L(0); PG8_MMA(1, 0, At, B0); PG8_BAR; PG8_SCHED;
            PG8_STAGE(PG8_SB(1, 1), b3 + hstepB, voffB);
            PG8_WAIT_V(6); PG8_BAR; PG8_MMA(1, 1, At, B1); PG8_BAR;
        }
        E(acc, cur, wr, wc, fr, fq, lds);
        if (!has_next) break;
#pragma unroll
        for (int a = 0; a < 2; ++a)
#pragma unroll
            for (int b = 0; b < 2; ++b)
#pragma unroll
                for (int m = 0; m < 4; ++m)
#pragma unroll
                    for (int n = 0; n < 2; ++n) { f32x2 z0, z1; asm volatile("v_mov_b64 %0, 0\n\tv_mov_b64 %1, 0" : "=v"(z0), "=v"(z1)); acc[a][b][m][n] = (f32x4){z0[0], z0[1], z1[0], z1[1]}; }
        cur = nxt; cA = nA; cB = nB; ++ui;
    }
    PG8_WAIT_V(0);
    if (wr == 0) PG8_BAR;
    PG8_BAR;
#undef PG8_SA
#undef PG8_SB
#undef PG8_STAGE
#undef PG8_LDA
#undef PG8_LDB
#undef PG8_MMA
#undef PG8_WAIT_V
#undef PG8_WAIT_L
#undef PG8_BAR
#undef PG8_SCHED
#undef PG8_UA
#undef PG8_UB
}
}
using pg8::Unit;
typedef f32x4 Acc[2][2][4][2];

__device__ __forceinline__ float row_rstd(const float* part, int row, int fr, int fq) {
    const f32x4 p = *(const f32x4*)(part + (size_t)row * 16 + 4 * fq);
    float s = (p[0] + p[1]) + (p[2] + p[3]);
    const int lane = (fq << 4) | fr; s += shx(s, 16, lane); s += shx(s, 32, lane);
    return rsqrtf(s * (1.0f / 1024.0f) + EPS);
}

__device__ __forceinline__ void rows_rstd8_lds(const LAS unsigned char* pl, int rl0, int fr, int fq, float (&rs)[8]) {
    float mine[2];
#pragma unroll
    for (int k = 0; k < 2; ++k) {
        const int r = 2 * fq + k; const LAS unsigned char* rp = pl + (rl0 + (r >> 2) * 128 + (r & 3) * 16) * 64;
        const f32x4 p0 = *(const LAS f32x4*)(rp), p1 = *(const LAS f32x4*)(rp + 16), p2 = *(const LAS f32x4*)(rp + 32), p3 = *(const LAS f32x4*)(rp + 48);
        const f32x4 q = (p0 + p1) + (p2 + p3);
        mine[k] = __builtin_amdgcn_rsqf(((q[0] + q[1]) + (q[2] + q[3])) * (1.0f / 1024.0f) + EPS);
    }
#pragma unroll
    for (int q = 0; q < 4; ++q) {
        rs[2 * q] = __int_as_float(__builtin_amdgcn_ds_bpermute(((q << 4) | fr) << 2, __float_as_int(mine[0])));
        rs[2 * q + 1] = __int_as_float(__builtin_amdgcn_ds_bpermute(((q << 4) | fr) << 2, __float_as_int(mine[1])));
    }
}
__device__ __forceinline__ void rows_rstd8(const float* part, int row0, int fr, int fq, float (&rs)[8]) {
    f32x4 pv[8];
#pragma unroll
    for (int r = 0; r < 8; ++r) pv[r] = *(const f32x4*)(part + (size_t)(row0 + (r >> 2) * 128 + (r & 3) * 16) * 16 + 4 * fq);
    const int lane = (fq << 4) | fr;
#pragma unroll
    for (int r = 0; r < 8; ++r) { float s_ = (pv[r][0] + pv[r][1]) + (pv[r][2] + pv[r][3]); s_ += shx(s_, 16, lane); s_ += shx(s_, 32, lane); rs[r] = rsqrtf(s_ * (1.0f / 1024.0f) + EPS); }
}
struct EpiFfnIn {
    static constexpr bool PERM = true, PARTPF = true;
    bf16_t* U; const float* part; unsigned* cnt;
    __device__ __forceinline__ void operator()(const Acc& acc, const Unit& u, int wr, int wc, int fr, int fq, LAS unsigned char* lds) const {
        const int row0 = u.pm * 256 + wr * 64 + fr, col0 = u.pn * 128 + wc * 32 + 8 * fq;
        float rsv[8]; rows_rstd8_lds(lds + pg8::STAGE_BYTES, wr * 64 + fr, fr, fq, rsv);
#pragma unroll
        for (int ai = 0; ai < 2; ++ai)
#pragma unroll
            for (int m = 0; m < 4; ++m) {
                const int row = row0 + ai * 128 + m * 16; const float rs = rsv[ai * 4 + m];
                const float rsn = rs * -1.4426950409f, rs2 = rs * rs; unsigned wv[4];
#pragma unroll
                for (int n = 0; n < 2; ++n)
#pragma unroll
                    for (int e2 = 0; e2 < 2; ++e2) {
                        const f32x2 a = {acc[ai][0][m][n][2 * e2], acc[ai][0][m][n][2 * e2 + 1]}, b = {acc[ai][1][m][n][2 * e2], acc[ai][1][m][n][2 * e2 + 1]};
                        const f32x2 arg = a * rsn;
                        f32x2 d; d.x = __builtin_amdgcn_exp2f(arg.x); d.y = __builtin_amdgcn_exp2f(arg.y); d = d + 1.0f;
                        f32x2 r; r.x = __builtin_amdgcn_rcpf(d.x); r.y = __builtin_amdgcn_rcpf(d.y);
                        const f32x2 o2 = ((a * b) * r) * rs2;
                        wv[n * 2 + e2] = cvt_pk_bf16(o2.x, o2.y); }
                u32x4 w; w.x = wv[0]; w.y = wv[1]; w.z = wv[2]; w.w = wv[3];
                gst16(U + (size_t)row * DFF + col0, w);
            }
        if (cnt && u.pm >= 128) {
            asm volatile("s_waitcnt vmcnt(0)" ::: "memory");
            __builtin_amdgcn_fence(__ATOMIC_RELEASE, "agent");
            asm volatile("s_waitcnt vmcnt(0)" ::: "memory");
            if (fr == 0 && fq == 0) __hip_atomic_fetch_add(cnt + 64 * (u.pm - 128), 1u, __ATOMIC_RELAXED, __HIP_MEMORY_SCOPE_AGENT);
        }
    }
};
struct EpiRes {
    static constexpr bool PERM = true, PARTPF = false;
    float* hmain; float* htail; bf16_t* hb; float* part; float scale; const float *xp, *xs, *xm; int first;
    __device__ __forceinline__ const float* rsrc(int row) const {
        if (!first) return hrow2(hmain, htail, row);
        const char* b0 = (const char*)xp + (size_t)row * (D * 4);
        const char* b1 = (const char*)xs + (size_t)(row - ROW_SAMPLE) * (D * 4);
        const char* b2 = (const char*)xm + (size_t)((row - ROW_META) & 15) * (D * 4);
        return (const float*)(row < ROW_SAMPLE ? b0 : (row < ROW_META ? b1 : b2));
    }
    __device__ __forceinline__ void operator()(const Acc& acc, const Unit& u, int wr, int wc, int fr, int fq, LAS unsigned char* lds) const {
        const int row0 = u.pm * 256 + wr * 64 + fr, col0 = u.pn * 256 + wc * 32 + 8 * fq, lane = (fq << 4) | fr;
#pragma unroll
        for (int ai = 0; ai < 2; ++ai) {
            f32x4 x[4][2][2];
#pragma unroll
            for (int m = 0; m < 4; ++m) { const int rr = row0 + ai * 128 + m * 16; const float* hp = rsrc(rr) + col0; const float keep = (first && rr >= ROW_PAD) ? 0.f : 1.f;
#pragma unroll
                for (int bj = 0; bj < 2; ++bj)
#pragma unroll
                    for (int n = 0; n < 2; ++n) x[m][bj][n] = gld16f(hp + bj * 128 + n * 4) * keep; }
#pragma unroll
            for (int m = 0; m < 4; ++m) {
                const int row = row0 + ai * 128 + m * 16; float* hp = hrow2(hmain, htail, row) + col0; bf16_t* bp = hb + (size_t)row * D + col0; float ss = 0.f;
#pragma unroll
                for (int bj = 0; bj < 2; ++bj) {
                    const f32x4 v0 = x[m][bj][0] + acc[ai][bj][m][0] * scale, v1 = x[m][bj][1] + acc[ai][bj][m][1] * scale;
                    gst16f(hp + bj * 128, v0); gst16f(hp + bj * 128 + 4, v1);
                    ss += ((v0[0] * v0[0] + v0[1] * v0[1]) + (v0[2] * v0[2] + v0[3] * v0[3])) + ((v1[0] * v1[0] + v1[1] * v1[1]) + (v1[2] * v1[2] + v1[3] * v1[3]));
                    u32x4 w; w.x = cvt_pk_bf16(v0[0], v0[1]); w.y = cvt_pk_bf16(v0[2], v0[3]); w.z = cvt_pk_bf16(v1[0], v1[1]); w.w = cvt_pk_bf16(v1[2], v1[3]);
                    gst16(bp + bj * 128, w); }
                ss += shx(ss, 16, lane); ss += shx(ss, 32, lane);
                if (fq == 0) part[(size_t)row * 16 + 4 * u.pn + wc] = ss;
            }
            asm volatile("" ::: "memory");
        }
    }
};
template <int ACT>
__device__ __forceinline__ void inproj_store(const Acc& acc, bf16_t* dst, int row0, int col0, const float (&rsv)[8], const float (&ol)[2][8], float* const (&cdst)[8]) {
#pragma unroll
    for (int ai = 0; ai < 2; ++ai)
#pragma unroll
        for (int m = 0; m < 4; ++m) {
            const int row = row0 + ai * 128 + m * 16; const float rs = rsv[ai * 4 + m];
#pragma unroll
            for (int bj = 0; bj < 2; ++bj) {
                float o[8];
#pragma unroll
                for (int n = 0; n < 2; ++n)
#pragma unroll
                    for (int e2 = 0; e2 < 2; ++e2) {
                        const f32x2 a2 = {acc[ai][bj][m][n][2 * e2], acc[ai][bj][m][n][2 * e2 + 1]}; f32x2 o2;
                        if (ACT == 0) o2 = a2 * rs;
                        else {
                            f32x2 arg, x = a2 * rs;
                            if (ACT == 1) arg = a2 * (rs * -1.4426950409f);
                            else if (ACT == 2) arg = a2 * (rs * 1.4426950409f);
                            else { const f32x2 x2 = x * x; arg = (x * (-1.4426950409f * 1.5957691216f)) * (x2 * 0.044715f + 1.0f); }
                            f32x2 d; d.x = __builtin_amdgcn_exp2f(arg.x); d.y = __builtin_amdgcn_exp2f(arg.y); d = d + 1.0f;
                            f32x2 r; r.x = __builtin_amdgcn_rcpf(d.x); r.y = __builtin_amdgcn_rcpf(d.y);
                            if (ACT == 2) { const f32x2 l2 = {ol[bj][n * 4 + 2 * e2], ol[bj][n * 4 + 2 * e2 + 1]}; o2 = l2 * r; } else o2 = x * r;
                        }
                        o[n * 4 + 2 * e2] = o2.x; o[n * 4 + 2 * e2 + 1] = o2.y; }
                u32x4 w; w.x = cvt_pk_bf16(o[0], o[1]); w.y = cvt_pk_bf16(o[2], o[3]); w.z = cvt_pk_bf16(o[4], o[5]); w.w = cvt_pk_bf16(o[6], o[7]);
                gst16(dst + (size_t)row * D + col0 + bj * 128, w);
                if (ACT == 0 && cdst[ai * 4 + m]) { float* cd = cdst[ai * 4 + m]; gst16f(cd + col0 + bj * 128, (f32x4){o[0], o[1], o[2], o[3]}); gst16f(cd + col0 + bj * 128 + 4, (f32x4){o[4], o[5], o[6], o[7]}); }
            }
        }
}
struct EpiHgrnIn {
    static constexpr bool PERM = true, PARTPF = true;
    bf16_t *Q, *KK, *V, *G; const float* part; const float* oml;
    __device__ __forceinline__ void operator()(const Acc& acc, const Unit& u, int wr, int wc, int fr, int fq, LAS unsigned char* lds) const {
        const int region = u.pn >> 2;
        const int row0 = u.pm * 256 + wr * 64 + fr, col0 = (u.pn & 3) * 256 + wc * 32 + 8 * fq;
        float rsv[8]; rows_rstd8_lds(lds + pg8::STAGE_BYTES, wr * 64 + fr, fr, fq, rsv);
        float ol[2][8]; float* cd[8];
#pragma unroll
        for (int r = 0; r < 8; ++r) { cd[r] = nullptr; ol[0][r] = 0.f; ol[1][r] = 0.f; }
        if (region == 0) inproj_store<1>(acc, Q, row0, col0, rsv, ol, cd);
        else if (region == 1) {
#pragma unroll
            for (int bj = 0; bj < 2; ++bj) { const f32x4 a = *(const f32x4*)(oml + col0 + bj * 128), b = *(const f32x4*)(oml + col0 + bj * 128 + 4);
#pragma unroll
                for (int e = 0; e < 4; ++e) { ol[bj][e] = a[e]; ol[bj][4 + e] = b[e]; } }
            inproj_store<2>(acc, KK, row0, col0, rsv, ol, cd);
        }
        else if (region == 2) inproj_store<0>(acc, V, row0, col0, rsv, ol, cd);
        else inproj_store<1>(acc, G, row0, col0, rsv, ol, cd);
    }
};
struct EpiRgIn {
    static constexpr bool PERM = true, PARTPF = true;
    bf16_t *XB, *GG; const float* part; float* conv_p; float* conv_s;
    __device__ __forceinline__ void operator()(const Acc& acc, const Unit& u, int wr, int wc, int fr, int fq, LAS unsigned char* lds) const {
        const int region = u.pn >> 2;
        const int row0 = u.pm * 256 + wr * 64 + fr, col0 = (u.pn & 3) * 256 + wc * 32 + 8 * fq;
        float rsv[8]; rows_rstd8_lds(lds + pg8::STAGE_BYTES, wr * 64 + fr, fr, fq, rsv);
        float ol[2][8]; float* cd[8];
#pragma unroll
        for (int r = 0; r < 8; ++r) { cd[r] = nullptr; ol[0][r] = 0.f; ol[1][r] = 0.f; }
        if (region == 0) {
            if (u.pm == 31 || u.pm == 63 || u.pm == 95 || u.pm >= 127) {
#pragma unroll
                for (int r = 0; r < 8; ++r) { const int row = row0 + (r >> 2) * 128 + (r & 3) * 16;
                    if (row < ROW_SAMPLE) { const int p = row & 8191; if (p >= 8189) cd[r] = conv_p + ((size_t)(row >> 13) * 3 + (p - 8189)) * D; }
                    else if (row < ROW_META) { const int p = row & 15; if (p >= 13) cd[r] = conv_s + ((size_t)((row - ROW_SAMPLE) >> 4) * 3 + (p - 13)) * D; } }
            }
            inproj_store<0>(acc, XB, row0, col0, rsv, ol, cd);
        } else inproj_store<3>(acc, GG, row0, col0, rsv, ol, cd);
    }
};
__device__ __forceinline__ float expm1_fast(float x) {
    const float p = x * (1.0f + x * (0.5f + x * (0.16666667f + x * (0.041666668f + x * (0.0083333338f + x * 0.0013888889f)))));
    return x > -0.25f ? p : __expf(x) - 1.0f;
}
struct EpiGate {
    static constexpr bool PERM = true, PARTPF = false; const float* part;
    const bf16_t* CF; bf16_t *OM, *UU; const float *ba, *bx, *sp;
    __device__ __forceinline__ void operator()(const Acc& acc, const Unit& u, int wr, int wc, int fr, int fq, LAS unsigned char* lds) const {
        const int row0 = u.pm * 256 + wr * 64 + fr, col0 = u.pn * 128 + wc * 32 + 8 * fq;
        constexpr float NL2E = -1.4426950409f;
#pragma unroll
        for (int n = 0; n < 2; ++n) {
            const f32x4 vba = *(const f32x4*)(ba + col0 + 4 * n) * NL2E, vbx = *(const f32x4*)(bx + col0 + 4 * n) * NL2E, vsp = *(const f32x4*)(sp + col0 + 4 * n) * (8.0f * NL2E);
            u32x2 cw[8];
#pragma unroll
            for (int r = 0; r < 8; ++r) cw[r] = *(const u32x2*)(CF + (size_t)(row0 + (r >> 2) * 128 + (r & 3) * 16) * D + col0 + 4 * n);
#pragma unroll
            for (int ai = 0; ai < 2; ++ai)
#pragma unroll
                for (int m = 0; m < 4; ++m) {
                    const size_t off = (size_t)(row0 + ai * 128 + m * 16) * D + col0 + 4 * n;
                    const u32x2 c2 = cw[ai * 4 + m]; unsigned wom[2], wuu[2];
#pragma unroll
                    for (int e2 = 0; e2 < 2; ++e2) {
                        const f32x2 ar = {acc[ai][0][m][n][2 * e2], acc[ai][0][m][n][2 * e2 + 1]}, ax = {acc[ai][1][m][n][2 * e2], acc[ai][1][m][n][2 * e2 + 1]};
                        const f32x2 br = {vba[2 * e2], vba[2 * e2 + 1]}, bxx = {vbx[2 * e2], vbx[2 * e2 + 1]}, sp2 = {vsp[2 * e2], vsp[2 * e2 + 1]};
                        const unsigned cwd = e2 ? c2.y : c2.x; const f32x2 cf = {bf_lo(cwd), bf_hi(cwd)};
                        f32x2 t = ar * NL2E + br; f32x2 d; d.x = __builtin_amdgcn_exp2f(t.x); d.y = __builtin_amdgcn_exp2f(t.y); d = d + 1.0f;
                        f32x2 r; r.x = __builtin_amdgcn_rcpf(d.x); r.y = __builtin_amdgcn_rcpf(d.y);
                        t = ax * NL2E + bxx; d.x = __builtin_amdgcn_exp2f(t.x); d.y = __builtin_amdgcn_exp2f(t.y); d = d + 1.0f;
                        f32x2 ig; ig.x = __builtin_amdgcn_rcpf(d.x); ig.y = __builtin_amdgcn_rcpf(d.y);
                        t = r * sp2; f32x2 ea; ea.x = __builtin_amdgcn_exp2f(t.x); ea.y = __builtin_amdgcn_exp2f(t.y);
                        const f32x2 om = 1.0f - ea;
                        t = om * (ea + 1.0f); f32x2 sq; sq.x = __builtin_amdgcn_sqrtf(t.x); sq.y = __builtin_amdgcn_sqrtf(t.y);
                        const f32x2 uu = (sq * ig) * cf;
                        wom[e2] = cvt_pk_bf16(om.x, om.y); wuu[e2] = cvt_pk_bf16(uu.x, uu.y); }
                    u32x2 w; w.x = wom[0]; w.y = wom[1]; gst8u(OM + off, w);
                    w.x = wuu[0]; w.y = wuu[1]; gst8u(UU + off, w);
                }
            asm volatile("" ::: "memory");
        }
    }
};

__device__ __forceinline__ void convert_tile(const float* src, int ldsrc, int K, const float* gvec, bf16_t* dst, int map, int t, int tid) {
    const int nk = K >> 7, tn = t / nk, tk = t - tn * nk, n0 = tn * 256, k0 = tk * 128 + (tid >> 6) * 16, lane = tid & 63;
    int c0 = n0 + 4 * lane; if (map) { const int pn = n0 >> 8; c0 = (lane < 32 ? 128 * pn + 4 * lane : DFF + 128 * pn + 4 * (lane - 32)); }
    const float* sp_ = src + (size_t)k0 * ldsrc + c0;
    f32x4 v[16];
#pragma unroll
    for (int j = 0; j < 16; ++j) v[j] = gld16f(sp_ + (size_t)j * ldsrc);
    if (gvec) {
#pragma unroll
        for (int j = 0; j < 16; ++j) v[j] *= gvec[k0 + j];
    }
    bf16_t* dp = dst + (size_t)(n0 + 4 * lane) * K + k0;
#pragma unroll
    for (int q = 0; q < 4; ++q) {
        u32x4 w0, w1;
        w0.x = cvt_pk_bf16(v[0][q], v[1][q]); w0.y = cvt_pk_bf16(v[2][q], v[3][q]); w0.z = cvt_pk_bf16(v[4][q], v[5][q]); w0.w = cvt_pk_bf16(v[6][q], v[7][q]);
        w1.x = cvt_pk_bf16(v[8][q], v[9][q]); w1.y = cvt_pk_bf16(v[10][q], v[11][q]); w1.z = cvt_pk_bf16(v[12][q], v[13][q]); w1.w = cvt_pk_bf16(v[14][q], v[15][q]);
        gst16(dp + (size_t)q * K, w0); gst16(dp + (size_t)q * K + 8, w1);
    }
}

__device__ __forceinline__ void phase_prep(LAS unsigned char* lds) { Params p; LOADP(ws); LOADP(out); LOADP(x_prompt); LOADP(x_sample); LOADP(meta); LOADP(a_lb); LOADP(b_lambda); LOADP(b_wa); LOADP(b_wx); LOADP(ffn_w_in); LOADP(ffn_norm); LOADP(ffn_w_out); LOADP(a_w_in); LOADP(mix_norm); LOADP(a_w_out); LOADP(b_w_in); LOADP(b_w_out);
    const int tid = otid(), G = gridDim.x, bid = obid(), lane = tid & 63, wave = tid >> 6;
    unsigned char* ws = p.ws;
    {
        float* hmain = p.out; float* htail = (float*)(ws + WS_HTAIL); bf16_t* hb = (bf16_t*)(ws + WS_HB); float* part = (float*)(ws + WS_PART);
        for (int rbase = bid * 8 + wave; rbase < MP; rbase += G * 8 * 4) {
            f32x4 x[4][4]; int rows[4];
#pragma unroll
            for (int k = 0; k < 4; ++k) { const int row = rbase + k * G * 8; rows[k] = row;
                const float* src = nullptr;
                if (row < ROW_SAMPLE) src = p.x_prompt + (size_t)row * D;
                else if (row < ROW_META) src = p.x_sample + (size_t)(row - ROW_SAMPLE) * D;
                else if (row < ROW_PAD) src = p.meta + (size_t)((row - ROW_META) & 15) * D;
#pragma unroll
                for (int i = 0; i < 4; ++i) x[k][i] = src ? gld16f(src + i * 256 + lane * 4) : (f32x4){0.f, 0.f, 0.f, 0.f}; }
#pragma unroll
            for (int k = 0; k < 4; ++k) { const int row = rows[k]; if (row >= MP) continue;
                float ss = 0.f;
#pragma unroll
                for (int i = 0; i < 4; ++i) { const int c = i * 256 + lane * 4; const f32x4 v = x[k][i];
                    ss += (v[0] * v[0] + v[1] * v[1]) + (v[2] * v[2] + v[3] * v[3]);
                    u32x2 w; w.x = cvt_pk_bf16(v[0], v[1]); w.y = cvt_pk_bf16(v[2], v[3]); gst8u(hb + (size_t)row * D + c, w); }
#pragma unroll
                for (int o = 32; o >= 1; o >>= 1) ss += shx(ss, o, lane);
                if (lane < 16) part[(size_t)row * 16 + lane] = lane == 0 ? ss : 0.f;
            }
        }
    }
    {
        float* oml = (float*)(ws + WS_VEC); float* sp = oml + 1024;
        for (int i = bid * NTHR + tid; i < 1024; i += G * NTHR) {
            oml[i] = 1.0f / (1.0f + expf(p.a_lb[i] - p.a_lb[1024 + i]));
            const float l = -p.b_lambda[i]; sp[i] = l > 20.f ? l : log1pf(expf(l));
        }
        bf16_t* wg = (bf16_t*)(ws + W_G);
        for (int i = bid * NTHR + tid; i < 8 * 256 * 128; i += G * NTHR) {
            const int pn = i >> 15, nrow = (i >> 7) & 255, kk = i & 127;
            const float* w = nrow < 128 ? p.b_wa : p.b_wx; const float v = w[((size_t)pn * 128 + kk) * 128 + (nrow & 127)];
            wg[i] = (bf16_t)(cvt_pk_bf16(v, 0.f) & 0xffffu);
        }
    }
    for (int w = bid; w < 1312; w += G) {
        int t = w;
        if (t < 704) { const int i = t / 176; t -= i * 176; convert_tile(p.ffn_w_in + (size_t)i * D * 2 * DFF, 2 * DFF, D, p.ffn_norm + (size_t)i * D, (bf16_t*)(ws + W_FFN_IN + i * SZ_FFN_IN), 1, t, tid); continue; }
        t -= 704;
        if (t < 352) { const int i = t / 88; t -= i * 88; convert_tile(p.ffn_w_out + (size_t)i * DFF * D, D, DFF, nullptr, (bf16_t*)(ws + W_FFN_OUT + i * SZ_FFN_OUT), 0, t, tid); continue; }
        t -= 352;
        if (t < 128) { convert_tile(p.a_w_in, 4096, D, p.mix_norm, (bf16_t*)(ws + W_A_IN), 0, t, tid); continue; }
        t -= 128;
        if (t < 32) { convert_tile(p.a_w_out, D, D, nullptr, (bf16_t*)(ws + W_A_OUT), 0, t, tid); continue; }
        t -= 32;
        if (t < 64) { convert_tile(p.b_w_in, 2048, D, p.mix_norm + D, (bf16_t*)(ws + W_B_IN), 0, t, tid); continue; }
        t -= 64;
        convert_tile(p.b_w_out, D, D, nullptr, (bf16_t*)(ws + W_B_OUT), 0, t, tid);
    }
}

typedef short bf16x4 __attribute__((ext_vector_type(4)));
template <int CTRL> __device__ __forceinline__ float dpp_f(float x) { return __int_as_float(__builtin_amdgcn_update_dpp(0, __float_as_int(x), CTRL, 0xf, 0xf, true)); }
__device__ __forceinline__ float bperm(int srclane, float v) { return __int_as_float(__builtin_amdgcn_ds_bpermute(srclane << 2, __float_as_int(v))); }
constexpr int GL_QD = 0, GL_KD = 4352, GL_KKT = 8704, GL_VT = 13824, GL_DEC = 18944, GL_RED = 19456, GL_BUF = 19712, GL_GRP = 2 * GL_BUF;

#define GAS __attribute__((address_space(1)))
__device__ __forceinline__ u32x4 gld16(const bf16_t* p) { return *(const GAS u32x4*)(const GAS void*)p; }
__device__ __forceinline__ u32x2 gld8(const bf16_t* p) { return *(const GAS u32x2*)(const GAS void*)p; }
__device__ __forceinline__ void gst8(bf16_t* p, u32x2 v) { *(GAS u32x2*)(GAS void*)p = v; }
template <bool OUT>
__device__ __forceinline__ void gla_mfma(LAS unsigned char* lds, const bf16_t* Qb, const bf16_t* Kb, const bf16_t* Vb, const bf16_t* Gb, bf16_t* Yb, int row0, int nblk, int h,
                                         const float* Sin, float* Sout, float* Dout, const float* onorm, int tid, bool tin, bool tout) {
    const int g = tid >> 8, gt = tid & 255, w = gt >> 6, lane = tid & 63, fr = lane & 15, quad = lane >> 4, g8 = gt >> 4;
    LAS unsigned char* L0 = lds + g * GL_GRP;
    f32x4 S[8][2];
    {
        if (tin) {
            int tb = (w * 64 + lane) * 4; asm volatile("" : "+v"(tb)); const GAS f32x4* sp4 = (const GAS f32x4*)(const GAS void*)(Sin + tb);
#pragma unroll
            for (int m = 0; m < 8; ++m)
#pragma unroll
                for (int n = 0; n < 2; ++n) S[m][n] = sp4[(m * 2 + n) * 256];
        } else {
        int sb = (4 * quad) * 128 + 32 * w + fr; asm volatile("" : "+v"(sb)); const GAS float* sp_ = (const GAS float*)(const GAS void*)(Sin + sb);
#pragma unroll
        for (int m = 0; m < 8; ++m)
#pragma unroll
            for (int n = 0; n < 2; ++n)
#pragma unroll
                for (int i = 0; i < 4; ++i) S[m][n][i] = sp_[(16 * m + i) * 128 + 16 * n];
        }
    }
    float bsum[8];
#pragma unroll
    for (int j = 0; j < 8; ++j) bsum[j] = 0.f;
    const size_t coff = (size_t)h * 128 + 8 * g8;
    u32x4 kw = gld16(Kb + (size_t)(row0 + fr) * D + coff), vw = gld16(Vb + (size_t)(row0 + fr) * D + coff), qw = kw;
    if (OUT) qw = gld16(Qb + (size_t)(row0 + fr) * D + coff);
    auto stage_a = [&](LAS unsigned char* L, const u32x4 kwv, const u32x4 qwv, const u32x4 vwv) {
        const unsigned kk_[4] = {kwv.x, kwv.y, kwv.z, kwv.w}, qq_[4] = {qwv.x, qwv.y, qwv.z, qwv.w}, vv_[4] = {vwv.x, vwv.y, vwv.z, vwv.w};
        float kf[8], bb[8], bl[8];
#pragma unroll
        for (int j = 0; j < 8; ++j) { kf[j] = (j & 1) ? bf_hi(kk_[j >> 1]) : bf_lo(kk_[j >> 1]);
            float x = __builtin_amdgcn_logf(1.0f - kf[j]);
            x += dpp_f<0x111>(x); x += dpp_f<0x112>(x); x += dpp_f<0x114>(x); x += dpp_f<0x118>(x);
            bb[j] = x; }
#pragma unroll
        for (int j = 0; j < 8; ++j) bl[j] = bperm(lane | 15, bb[j]);
        float qd[8], kd[8], kx[8];
#pragma unroll
        for (int jp = 0; jp < 4; ++jp) {
            const f32x2 k2 = {kf[2 * jp], kf[2 * jp + 1]}, b2 = {bb[2 * jp], bb[2 * jp + 1]}, l2 = {bl[2 * jp], bl[2 * jp + 1]};
            const f32x2 df = l2 - b2; f32x2 e; e.x = __builtin_amdgcn_exp2f(df.x); e.y = __builtin_amdgcn_exp2f(df.y);
            const f32x2 kx2 = k2 * e; kx[2 * jp] = kx2.x; kx[2 * jp + 1] = kx2.y;
            if (OUT) { const f32x2 q2 = {bf_lo(qq_[jp]), bf_hi(qq_[jp])};
                f32x2 e1; e1.x = __builtin_amdgcn_exp2f(b2.x); e1.y = __builtin_amdgcn_exp2f(b2.y);
                f32x2 e2; e2.x = __builtin_amdgcn_exp2f(-b2.x); e2.y = __builtin_amdgcn_exp2f(-b2.y);
                const f32x2 qd2 = q2 * e1, kd2 = k2 * e2; qd[2 * jp] = qd2.x; qd[2 * jp + 1] = qd2.y; kd[2 * jp] = kd2.x; kd[2 * jp + 1] = kd2.y; } }
        if (OUT) {
            u32x4 wq, wk; wq.x = cvt_pk_bf16(qd[0], qd[1]); wq.y = cvt_pk_bf16(qd[2], qd[3]); wq.z = cvt_pk_bf16(qd[4], qd[5]); wq.w = cvt_pk_bf16(qd[6], qd[7]);
            wk.x = cvt_pk_bf16(kd[0], kd[1]); wk.y = cvt_pk_bf16(kd[2], kd[3]); wk.z = cvt_pk_bf16(kd[4], kd[5]); wk.w = cvt_pk_bf16(kd[6], kd[7]);
            *(LAS u32x4*)(L + GL_QD + fr * 272 + g8 * 16) = wq; *(LAS u32x4*)(L + GL_KD + fr * 272 + g8 * 16) = wk;
        }
#pragma unroll
        for (int j = 0; j < 8; j += 2) { const unsigned pk = cvt_pk_bf16(kx[j], kx[j + 1]);
            *(LAS unsigned short*)(L + GL_KKT + (8 * g8 + j) * 40 + fr * 2) = (unsigned short)(pk & 0xffffu);
            *(LAS unsigned short*)(L + GL_KKT + (8 * g8 + j + 1) * 40 + fr * 2) = (unsigned short)(pk >> 16);
            *(LAS unsigned short*)(L + GL_VT + (8 * g8 + j) * 40 + fr * 2) = (unsigned short)(vv_[j >> 1] & 0xffffu);
            *(LAS unsigned short*)(L + GL_VT + (8 * g8 + j + 1) * 40 + fr * 2) = (unsigned short)(vv_[j >> 1] >> 16); }
        if (fr == 0) { *(LAS f32x4*)(L + GL_DEC + g8 * 32) = (f32x4){__builtin_amdgcn_exp2f(bl[0]), __builtin_amdgcn_exp2f(bl[1]), __builtin_amdgcn_exp2f(bl[2]), __builtin_amdgcn_exp2f(bl[3])};
                       *(LAS f32x4*)(L + GL_DEC + g8 * 32 + 16) = (f32x4){__builtin_amdgcn_exp2f(bl[4]), __builtin_amdgcn_exp2f(bl[5]), __builtin_amdgcn_exp2f(bl[6]), __builtin_amdgcn_exp2f(bl[7])}; }
        if (!OUT) {
#pragma unroll
            for (int j = 0; j < 8; ++j) bsum[j] += bl[j];
        }
    };
    stage_a(L0, kw, qw, vw);
    if (nblk > 1) { const size_t o = (size_t)(row0 + 16 + fr) * D + coff; kw = gld16(Kb + o); vw = gld16(Vb + o); if (OUT) qw = gld16(Qb + o); }
    __syncthreads();
    for (int blk = 0; blk < nblk; ++blk) {
        const int rb = row0 + blk * 16;
        LAS unsigned char* L = L0 + (blk & 1) * GL_BUF;
        bf16x4 vfr[2];
#pragma unroll
        for (int n = 0; n < 2; ++n) vfr[n] = *(const LAS bf16x4*)(L + GL_VT + (32 * w + 16 * n + fr) * 40 + quad * 8);
        f32x4 o[2];
        if (OUT) {
            bf16x8 qf[4];
            f32x4 sc = (f32x4){0.f, 0.f, 0.f, 0.f};
#pragma unroll
            for (int kb = 0; kb < 4; ++kb) {
                const bf16x4 q0 = *(const LAS bf16x4*)(L + GL_QD + fr * 272 + (32 * kb + 4 * quad) * 2), q1 = *(const LAS bf16x4*)(L + GL_QD + fr * 272 + (32 * kb + 16 + 4 * quad) * 2);
                const bf16x4 k0 = *(const LAS bf16x4*)(L + GL_KD + fr * 272 + (32 * kb + 4 * quad) * 2), k1 = *(const LAS bf16x4*)(L + GL_KD + fr * 272 + (32 * kb + 16 + 4 * quad) * 2);
                qf[kb] = (bf16x8){q0[0], q0[1], q0[2], q0[3], q1[0], q1[1], q1[2], q1[3]};
                const bf16x8 kfv = (bf16x8){k0[0], k0[1], k0[2], k0[3], k1[0], k1[1], k1[2], k1[3]};
                sc = __builtin_amdgcn_mfma_f32_16x16x32_bf16(kfv, qf[kb], sc, 0, 0, 0);
            }
#pragma unroll
            for (int i = 0; i < 4; ++i) sc[i] = (4 * quad + i <= fr) ? sc[i] : 0.f;
            bf16x4 P; { const unsigned p0 = cvt_pk_bf16(sc[0], sc[1]), p1 = cvt_pk_bf16(sc[2], sc[3]); P = (bf16x4){(short)(p0 & 0xffffu), (short)(p0 >> 16), (short)(p1 & 0xffffu), (short)(p1 >> 16)}; }
#pragma unroll
            for (int n = 0; n < 2; ++n) {
                o[n] = (f32x4){0.f, 0.f, 0.f, 0.f};
#pragma unroll
                for (int kb = 0; kb < 4; ++kb) {
                    const unsigned a0 = cvt_pk_bf16(S[2 * kb][n][0], S[2 * kb][n][1]), a1 = cvt_pk_bf16(S[2 * kb][n][2], S[2 * kb][n][3]);
                    const unsigned a2 = cvt_pk_bf16(S[2 * kb + 1][n][0], S[2 * kb + 1][n][1]), a3 = cvt_pk_bf16(S[2 * kb + 1][n][2], S[2 * kb + 1][n][3]);
                    const bf16x8 sa = (bf16x8){(short)(a0 & 0xffffu), (short)(a0 >> 16), (short)(a1 & 0xffffu), (short)(a1 >> 16), (short)(a2 & 0xffffu), (short)(a2 >> 16), (short)(a3 & 0xffffu), (short)(a3 >> 16)};
                    o[n] = __builtin_amdgcn_mfma_f32_16x16x32_bf16(sa, qf[kb], o[n], 0, 0, 0);
                }
                asm volatile("s_nop 7\n\ts_nop 3" : "+v"(o[n]));
                o[n] = __builtin_amdgcn_mfma_f32_16x16x16bf16_1k(vfr[n], P, o[n], 0, 0, 0);
            }
            asm volatile("s_nop 7\n\ts_nop 7" : "+v"(o[0]), "+v"(o[1]));
        }
#pragma unroll
        for (int m = 0; m < 8; ++m) {
            const bf16x4 kkf = *(const LAS bf16x4*)(L + GL_KKT + (16 * m + fr) * 40 + quad * 8);
            const f32x4 dec = *(const LAS f32x4*)(L + GL_DEC + (16 * m + 4 * quad) * 4);
#pragma unroll
            for (int n = 0; n < 2; ++n) S[m][n] = __builtin_amdgcn_mfma_f32_16x16x16bf16_1k(kkf, vfr[n], S[m][n] * dec, 0, 0, 0);
        }
        if (blk + 1 < nblk) {
            stage_a(L0 + ((blk + 1) & 1) * GL_BUF, kw, qw, vw);
            if (blk + 2 < nblk) { const size_t o2 = (size_t)(rb + 32 + fr) * D + coff; kw = gld16(Kb + o2); vw = gld16(Vb + o2); if (OUT) qw = gld16(Qb + o2); }
        }
        if (!OUT) __syncthreads();
        if (OUT) {
            float ss = 0.f;
#pragma unroll
            for (int n = 0; n < 2; ++n) ss += (o[n][0] * o[n][0] + o[n][1] * o[n][1]) + (o[n][2] * o[n][2] + o[n][3] * o[n][3]);
            ss += shx(ss, 16, lane); ss += shx(ss, 32, lane);
            if (quad == 0) *(LAS float*)(L + GL_RED + (w * 16 + fr) * 4) = ss;
            const size_t yoff = (size_t)(rb + fr) * D + h * 128 + 32 * w + 4 * quad;
            const u32x2 g0 = gld8(Gb + yoff), g1 = gld8(Gb + yoff + 16);
            const f32x4 n0 = *(const f32x4*)(onorm + h * 128 + 32 * w + 4 * quad), n1 = *(const f32x4*)(onorm + h * 128 + 32 * w + 16 + 4 * quad);
            __syncthreads();
            const float tot = (*(const LAS float*)(L + GL_RED + fr * 4) + *(const LAS float*)(L + GL_RED + (16 + fr) * 4)) + (*(const LAS float*)(L + GL_RED + (32 + fr) * 4) + *(const LAS float*)(L + GL_RED + (48 + fr) * 4));
            const float rs = rsqrtf(tot * (1.0f / 128.0f) + EPS);
            u32x2 y0, y1;
            { const f32x2 a = {o[0][0], o[0][1]}, b = {o[0][2], o[0][3]}, c = {o[1][0], o[1][1]}, d = {o[1][2], o[1][3]};
              const f32x2 na = {n0[0], n0[1]}, nb = {n0[2], n0[3]}, nc = {n1[0], n1[1]}, nd = {n1[2], n1[3]};
              const f32x2 ga = {bf_lo(g0.x), bf_hi(g0.x)}, gb = {bf_lo(g0.y), bf_hi(g0.y)}, gc = {bf_lo(g1.x), bf_hi(g1.x)}, gd = {bf_lo(g1.y), bf_hi(g1.y)};
              const f32x2 ya = (a * rs) * (na * ga), yb = (b * rs) * (nb * gb), yc = (c * rs) * (nc * gc), yd = (d * rs) * (nd * gd);
              y0.x = cvt_pk_bf16(ya.x, ya.y); y0.y = cvt_pk_bf16(yb.x, yb.y); y1.x = cvt_pk_bf16(yc.x, yc.y); y1.y = cvt_pk_bf16(yd.x, yd.y); }
            gst8(Yb + yoff, y0); gst8(Yb + yoff + 16, y1);
        }
    }
    asm volatile("s_nop 7\n\ts_nop 7" : "+v"(S[7][0]), "+v"(S[7][1]), "+v"(S[6][0]), "+v"(S[6][1]));
    if (Sout && tout) {
        int tb = (w * 64 + lane) * 4; asm volatile("" : "+v"(tb)); GAS f32x4* sp4 = (GAS f32x4*)(GAS void*)(Sout + tb);
#pragma unroll
        for (int m = 0; m < 8; ++m)
#pragma unroll
            for (int n = 0; n < 2; ++n) sp4[(m * 2 + n) * 256] = S[m][n];
    }
    if (Sout && !tout) {
        int sb = (4 * quad) * 128 + 32 * w + fr; asm volatile("" : "+v"(sb)); float* sp_ = Sout + sb;
#pragma unroll
        for (int m = 0; m < 8; ++m)
#pragma unroll
            for (int n = 0; n < 2; ++n)
#pragma unroll
                for (int i = 0; i < 4; ++i) sp_[(16 * m + i) * 128 + 16 * n] = S[m][n][i];
    }
    if (!OUT && Dout && fr == 0) {
#pragma unroll
        for (int j = 0; j < 8; ++j) Dout[8 * g8 + j] = __builtin_amdgcn_exp2f(bsum[j]);
    }
}

__device__ __forceinline__ void gla_chunk_rows(int seq, int c, int& row0, int& nblk) { if (c == 0) { row0 = ROW_META + 16 * seq; nblk = 1; } else { row0 = 8192 * seq + 256 * (c - 1); nblk = 16; } }

__device__ __forceinline__ void phase_gla1(LAS unsigned char* lds) { Params p; LOADP(ws);
    unsigned char* ws = p.ws; float* SST = (float*)(ws + SC_SST); float* DC = (float*)(ws + SC_DC);
    const int tid = otid();
    for (int pi = obid(); pi < 512; pi += gridDim.x) {
        const int i = 2 * pi + (tid >> 8); int seq, h, c;
        if (i < 992) { seq = i / 248; const int r = i - seq * 248; h = r / 31; c = 1 + (r - h * 31); } else { seq = (i - 992) >> 3; h = (i - 992) & 7; c = 0; }
        int row0, nblk; gla_chunk_rows(seq, c, row0, nblk);
        const size_t sh = (size_t)(seq * 8 + h) * NCH;
        gla_mfma<false>(lds, nullptr, (const bf16_t*)(ws + SC_K), (const bf16_t*)(ws + SC_V), nullptr, nullptr, row0, nblk, h, (const float*)(ws + WS_ZERO), SST + (sh + c + 1) * 16384, DC + (sh + c) * 128, nullptr, tid, true, true);
        __syncthreads();
    }
}
__device__ __forceinline__ void phase_gla2() { Params p; LOADP(ws);
    unsigned char* ws = p.ws; float* SST = (float*)(ws + SC_SST); const float* DC = (const float*)(ws + SC_DC);
    for (int idx = obid() * NTHR + otid(); idx < 32 * 4096; idx += gridDim.x * NTHR) {
        const int sh = idx >> 12, e4 = idx & 4095, m = e4 >> 9, quad = (e4 >> 4) & 3, dk0 = 16 * m + 4 * quad;
        float* base = SST + (size_t)sh * NCH * 16384 + e4 * 4; const float* dcb = DC + (size_t)sh * NCH * 128 + dk0;
        f32x4 v[32];
#pragma unroll
        for (int c = 0; c < 32; ++c) v[c] = *(const f32x4*)(base + (size_t)(c + 1) * 16384);
#pragma unroll
        for (int cb = 0; cb < 4; ++cb) {
            f32x4 dv[8];
#pragma unroll
            for (int j = 0; j < 8; ++j) dv[j] = *(const f32x4*)(dcb + (size_t)(cb * 8 + j) * 128);
#pragma unroll
            for (int j = 0; j < 8; ++j) { const int c = cb * 8 + j; if (c >= 1) { v[c] += v[c - 1] * dv[j]; *(f32x4*)(base + (size_t)(c + 1) * 16384) = v[c]; } }
        }
    }
}
__device__ __forceinline__ void phase_gla3(LAS unsigned char* lds) { Params p; LOADP(ws); LOADP(out); LOADP(state_hgrn); LOADP(a_onorm);
    unsigned char* ws = p.ws; float* SST = (float*)(ws + SC_SST);
    const bf16_t *Qb = (const bf16_t*)(ws + SC_Q), *Kb = (const bf16_t*)(ws + SC_K), *Vb = (const bf16_t*)(ws + SC_V), *Gb = (const bf16_t*)(ws + SC_G); bf16_t* Yb = (bf16_t*)(ws + SC_G);
    const int tid = otid();
    for (int pi = obid(); pi < 592; pi += gridDim.x) {
        const int i = 2 * pi + (tid >> 8);
        int row0, nblk, h; const float* Sin = (const float*)(ws + WS_ZERO); float* Sout = nullptr;
        if (i < 1056) {
            int seq, c; if (i < 1024) { seq = i >> 8; h = (i >> 5) & 7; c = 1 + (i & 31); } else { seq = (i - 1024) >> 3; h = (i - 1024) & 7; c = 0; }
            gla_chunk_rows(seq, c, row0, nblk);
            if (c > 0) Sin = SST + ((size_t)(seq * 8 + h) * NCH + c) * 16384;
            if (c == 32) Sout = p.out + O_HP + (size_t)(seq * 8 + h) * 16384;
        } else {
            const int j = i - 1056, sidx = j >> 3; h = j & 7; row0 = ROW_SAMPLE + 16 * sidx; nblk = 1;
            Sin = p.state_hgrn + (size_t)(sidx * 8 + h) * 16384; Sout = p.out + O_HS + (size_t)(sidx * 8 + h) * 16384;
        }
        gla_mfma<true>(lds, Qb, Kb, Vb, Gb, Yb, row0, nblk, h, Sin, Sout, nullptr, p.a_onorm, tid, pi < 512, false);
        __syncthreads();
    }
}

__device__ __forceinline__ void unpack8(const u32x4 w, float (&x)[8]) { x[0] = bf_lo(w.x); x[1] = bf_hi(w.x); x[2] = bf_lo(w.y); x[3] = bf_hi(w.y); x[4] = bf_lo(w.z); x[5] = bf_hi(w.z); x[6] = bf_lo(w.w); x[7] = bf_hi(w.w); }
__device__ __forceinline__ void phase_conv() { Params p; LOADP(ws); LOADP(b_conv_b); LOADP(b_conv_w); LOADP(state_conv);
    unsigned char* ws = p.ws; const bf16_t* XB = (const bf16_t*)(ws + SC_XB); bf16_t* CF = (bf16_t*)(ws + SC_CF);
    const int tid = otid(), lane = tid & 63, wave = tid >> 6;
    for (int g = obid() * 8 + wave; g < MP / 16; g += gridDim.x * 8) {
        const int r0 = g * 16;
#pragma unroll
        for (int half = 0; half < 2; ++half) {
            const int c = half * 512 + lane * 8;
            if (r0 >= ROW_PAD) {
#pragma unroll
                for (int t = 0; t < 16; ++t) gst16(CF + (size_t)(r0 + t) * D + c, (u32x4){0u, 0u, 0u, 0u});
                continue;
            }
            u32x4 xw[16];
#pragma unroll
            for (int t = 0; t < 16; ++t) xw[t] = gld16(XB + (size_t)(r0 + t) * D + c);
            float hx[3][8];
            if (r0 < ROW_SAMPLE) {
                const int hb0 = (r0 & 8191) == 0 ? ROW_META + 16 * (r0 >> 13) + 13 : r0 - 3;
#pragma unroll
                for (int j = 0; j < 3; ++j) unpack8(gld16(XB + (size_t)(hb0 + j) * D + c), hx[j]);
            } else if (r0 < ROW_META) {
                const float* sc_ = p.state_conv + (size_t)((r0 - ROW_SAMPLE) >> 4) * 3 * D + c;
#pragma unroll
                for (int j = 0; j < 3; ++j) { const f32x4 a = *(const f32x4*)(sc_ + (size_t)j * D), b2 = *(const f32x4*)(sc_ + (size_t)j * D + 4);
#pragma unroll
                    for (int e = 0; e < 4; ++e) { hx[j][e] = a[e]; hx[j][4 + e] = b2[e]; } }
            } else {
#pragma unroll
                for (int j = 0; j < 3; ++j)
#pragma unroll
                    for (int e = 0; e < 8; ++e) hx[j][e] = 0.f;
            }
            float wv[4][8], bv[8];
#pragma unroll
            for (int j = 0; j < 4; ++j) { const f32x4 a = *(const f32x4*)(p.b_conv_w + (size_t)j * D + c), b2 = *(const f32x4*)(p.b_conv_w + (size_t)j * D + c + 4);
#pragma unroll
                for (int e = 0; e < 4; ++e) { wv[j][e] = a[e]; wv[j][4 + e] = b2[e]; } }
            { const f32x4 a = *(const f32x4*)(p.b_conv_b + c), b2 = *(const f32x4*)(p.b_conv_b + c + 4);
#pragma unroll
              for (int e = 0; e < 4; ++e) { bv[e] = a[e]; bv[4 + e] = b2[e]; } }
#pragma unroll
            for (int t = 0; t < 16; ++t) {
                float x[8], o[8]; unpack8(xw[t], x);
#pragma unroll
                for (int e = 0; e < 8; ++e) { o[e] = fmaf(x[e], wv[3][e], fmaf(hx[2][e], wv[2][e], fmaf(hx[1][e], wv[1][e], fmaf(hx[0][e], wv[0][e], bv[e]))));
                    hx[0][e] = hx[1][e]; hx[1][e] = hx[2][e]; hx[2][e] = x[e]; }
                u32x4 w; w.x = cvt_pk_bf16(o[0], o[1]); w.y = cvt_pk_bf16(o[2], o[3]); w.z = cvt_pk_bf16(o[4], o[5]); w.w = cvt_pk_bf16(o[6], o[7]);
                gst16(CF + (size_t)(r0 + t) * D + c, w);
            }
        }
    }
}
__device__ __forceinline__ void rg_chunk_rows(int seq, int c, int& row0, int& ntok) { if (c == 0) { row0 = ROW_META + 16 * seq; ntok = 16; } else { row0 = 8192 * seq + 64 * (c - 1); ntok = 64; } }
__device__ __forceinline__ void phase_scan1() { Params p; LOADP(ws);
    unsigned char* ws = p.ws; const bf16_t* OM = (const bf16_t*)(ws + SC_OM); const bf16_t* UU = (const bf16_t*)(ws + SC_UU); f32x4* AB = (f32x4*)(ws + SC_AB);
    const int tid = otid(), sub = tid >> 8, tt = tid & 255;
    for (int i = 2 * obid() + sub; i < 4 * (RCH - 1); i += 2 * gridDim.x) {
        const int seq = i / (RCH - 1), c = i % (RCH - 1);
        int row0, ntok; rg_chunk_rows(seq, c, row0, ntok);
        float a[4] = {1.f, 1.f, 1.f, 1.f}, h[4] = {0.f, 0.f, 0.f, 0.f};
#pragma unroll 16
        for (int t = 0; t < ntok; ++t) { const size_t o = (size_t)(row0 + t) * D + 4 * tt; const u32x2 om = gld8(OM + o), uu = gld8(UU + o);
            const float x0 = 1.0f - bf_lo(om.x), x1 = 1.0f - bf_hi(om.x), x2 = 1.0f - bf_lo(om.y), x3 = 1.0f - bf_hi(om.y);
            h[0] = fmaf(x0, h[0], bf_lo(uu.x)); h[1] = fmaf(x1, h[1], bf_hi(uu.x)); h[2] = fmaf(x2, h[2], bf_lo(uu.y)); h[3] = fmaf(x3, h[3], bf_hi(uu.y));
            a[0] *= x0; a[1] *= x1; a[2] *= x2; a[3] *= x3; }
        f32x4* ab = AB + (size_t)(seq * RCH + c) * 512 + 2 * tt;
        ab[0] = (f32x4){a[0], h[0], a[1], h[1]}; ab[1] = (f32x4){a[2], h[2], a[3], h[3]};
    }
}
__device__ __forceinline__ void phase_scan3() { Params p; LOADP(ws); LOADP(out); LOADP(state_rglru);
    unsigned char* ws = p.ws; const bf16_t* OM = (const bf16_t*)(ws + SC_OM); const bf16_t* UU = (const bf16_t*)(ws + SC_UU); const f32x4* AB = (const f32x4*)(ws + SC_AB);
    bf16_t* GY = (bf16_t*)(ws + SC_GG);
    const int tid = otid(), sub = tid >> 8, tt = tid & 255;
    for (int i = 2 * obid() + sub; i < 4 * RCH + 16; i += 2 * gridDim.x) {
        int row0, ntok; float h[4] = {0.f, 0.f, 0.f, 0.f}; float* hout = nullptr;
        if (i < 4 * RCH) {
            int seq, c; if (i < 512) { seq = i & 3; c = 128 - (i >> 2); } else { seq = i - 512; c = 0; }
            rg_chunk_rows(seq, c, row0, ntok);
#pragma unroll 16
            for (int j = 0; j < c; ++j) { const f32x4* ab = AB + (size_t)(seq * RCH + j) * 512 + 2 * tt; const f32x4 p0 = ab[0], p1 = ab[1];
                h[0] = fmaf(p0[0], h[0], p0[1]); h[1] = fmaf(p0[2], h[1], p0[3]); h[2] = fmaf(p1[0], h[2], p1[1]); h[3] = fmaf(p1[2], h[3], p1[3]); }
            if (c == RCH - 1) hout = p.out + O_RP + (size_t)seq * D;
        } else {
            const int s_ = i - 4 * RCH; row0 = ROW_SAMPLE + 16 * s_; ntok = 16;
            const f32x4 hh = *(const f32x4*)(p.state_rglru + (size_t)s_ * D + 4 * tt); h[0] = hh[0]; h[1] = hh[1]; h[2] = hh[2]; h[3] = hh[3]; hout = p.out + O_RS + (size_t)s_ * D;
        }
        for (int t0 = 0; t0 < ntok; t0 += 16) {
            u32x2 om[16], uu[16], gg[16];
#pragma unroll
            for (int t = 0; t < 16; ++t) { const size_t o = (size_t)(row0 + t0 + t) * D + 4 * tt; om[t] = gld8(OM + o); uu[t] = gld8(UU + o); gg[t] = gld8(GY + o); }
#pragma unroll
            for (int t = 0; t < 16; ++t) {
                h[0] = fmaf(1.0f - bf_lo(om[t].x), h[0], bf_lo(uu[t].x)); h[1] = fmaf(1.0f - bf_hi(om[t].x), h[1], bf_hi(uu[t].x));
                h[2] = fmaf(1.0f - bf_lo(om[t].y), h[2], bf_lo(uu[t].y)); h[3] = fmaf(1.0f - bf_hi(om[t].y), h[3], bf_hi(uu[t].y));
                u32x2 y; y.x = cvt_pk_bf16(h[0] * bf_lo(gg[t].x), h[1] * bf_hi(gg[t].x)); y.y = cvt_pk_bf16(h[2] * bf_lo(gg[t].y), h[3] * bf_hi(gg[t].y));
                gst8(GY + (size_t)(row0 + t0 + t) * D + 4 * tt, y); }
        }
        if (hout) *(f32x4*)(hout + 4 * tt) = (f32x4){h[0], h[1], h[2], h[3]};
    }
}
__device__ __forceinline__ void phase_final(const float* part) { Params p; LOADP(out); LOADP(final_norm);
    const int tid = otid(), lane = tid & 63, wave = tid >> 6;
    f32x4 gn[4];
#pragma unroll
    for (int i = 0; i < 4; ++i) gn[i] = *(const f32x4*)(p.final_norm + i * 256 + lane * 4);
    const int G8 = gridDim.x * 8;
    for (int rbase = obid() * 8 + wave; rbase < ROW_META; rbase += G8 * 4) {
        f32x4 x[4][4]; float sv[4];
#pragma unroll
        for (int k = 0; k < 4; ++k) { const int row = rbase + k * G8; const bool ok = row < ROW_META; const int rr = ok ? row : 0;
            sv[k] = lane < 16 ? part[(size_t)rr * 16 + lane] : 0.f;
#pragma unroll
            for (int i = 0; i < 4; ++i) x[k][i] = gld16f(p.out + (size_t)rr * D + i * 256 + lane * 4); }
#pragma unroll
        for (int k = 0; k < 4; ++k) { const int row = rbase + k * G8; if (row >= ROW_META) continue;
            float s_ = sv[k];
#pragma unroll
            for (int o = 8; o >= 1; o >>= 1) s_ += shx(s_, o, lane);
            s_ = __int_as_float(__builtin_amdgcn_readfirstlane(__float_as_int(s_)));
            const float rs = rsqrtf(s_ * (1.0f / 1024.0f) + EPS); float* hp = p.out + (size_t)row * D;
#pragma unroll
            for (int i = 0; i < 4; ++i) gst16f(hp + i * 256 + lane * 4, x[k][i] * rs * gn[i]); }
    }
}


#define XB_TMO      128
#define XB_XCNT(j)  (256  + 64 * (j))
#define XB_XSUB(j)  (1280 + 64 * (j))
#define XB_XGEN(j)  (2304 + 64 * (j))
#define XB_TOP      3328
#define XB_TOPGEN   3392
#define XCD_BAR_WORDS 3456
#define XB_SPIN_CAP (1u << 18)
__device__ __forceinline__ unsigned xb_ld(unsigned* p)              { return __hip_atomic_load(p, __ATOMIC_RELAXED, __HIP_MEMORY_SCOPE_AGENT); }
__device__ __forceinline__ unsigned xb_add(unsigned* p, unsigned v) { return __hip_atomic_fetch_add(p, v, __ATOMIC_RELAXED, __HIP_MEMORY_SCOPE_AGENT); }
__device__ __forceinline__ unsigned xb_xcc_id() { return (unsigned)__builtin_amdgcn_s_getreg((3 << 11) | 20) & 0xFu; }
#define XB_SPIN(cond, bar) do { unsigned _sp = 0; while (cond) { __builtin_amdgcn_s_sleep(1); \
    if ((++_sp & 255u) == 0u) { if (xb_ld(&(bar)[XB_TMO])) break; if (_sp > XB_SPIN_CAP) { atomicAdd(&(bar)[XB_TMO], 1u); break; } } } } while (0)
struct XcdBarrier { unsigned* bar; unsigned x; volatile LAS unsigned* st; };
__device__ __forceinline__ XcdBarrier xcd_barrier_post(unsigned* bar, volatile LAS unsigned* st) {
    XcdBarrier b; b.bar = bar; b.x = xb_xcc_id(); b.st = st;
    if (threadIdx.x == 0) (void)xb_add(&bar[XB_XCNT(b.x)], 1u);
    return b;
}
__device__ __forceinline__ void xcd_barrier_complete(unsigned* bar, unsigned x, unsigned& nloc, unsigned& nx) {
    const unsigned G = gridDim.x * gridDim.y * gridDim.z;
    unsigned sum, cnt, mine, sp = 0u;
    for (;;) {
        sum = 0u; cnt = 0u; mine = 0u;
#pragma unroll
        for (unsigned j = 0; j < 16; ++j) { const unsigned c = xb_ld(&bar[XB_XCNT(j)]); sum += c; cnt += (c > 0u) ? 1u : 0u; mine = (j == x) ? c : mine; }
        if (sum == G) break;
        __builtin_amdgcn_s_sleep(1);
        if ((++sp & 255u) == 0u) { if (xb_ld(&bar[XB_TMO])) break; if (sp > XB_SPIN_CAP) { atomicAdd(&bar[XB_TMO], 1u); break; } }
    }
    nloc = mine > 0u ? mine : 1u; nx = cnt > 0u ? cnt : 1u;
}
__device__ __forceinline__ void xcd_barrier(const XcdBarrier& b) {
    asm volatile("s_waitcnt vmcnt(0)" ::: "memory");
    __syncthreads();
    if (threadIdx.x == 0) {
        unsigned* bar = b.bar;
        __builtin_amdgcn_s_waitcnt(0);
        unsigned nloc = b.st[0], nx = b.st[1];
        if (nloc == 0u) { xcd_barrier_complete(bar, b.x, nloc, nx); b.st[0] = nloc; b.st[1] = nx; }
        const unsigned old = xb_add(&bar[XB_XSUB(b.x)], 1u);
        const unsigned gen = old / nloc;
        if (old + 1u == (gen + 1u) * nloc) {
            __builtin_amdgcn_fence(__ATOMIC_RELEASE, "agent");
            asm volatile("s_waitcnt vmcnt(0)" ::: "memory");
            const unsigned og = xb_add(&bar[XB_TOP], 1u);
            const unsigned tg = og / nx;
            if (og + 1u == (tg + 1u) * nx) xb_add(&bar[XB_TOPGEN], 1u);
            else XB_SPIN(xb_ld(&bar[XB_TOPGEN]) == tg, bar);
            __builtin_amdgcn_fence(__ATOMIC_ACQUIRE, "agent");
            xb_add(&bar[XB_XGEN(b.x)], 1u);
            asm volatile("s_waitcnt vmcnt(0)" ::: "memory");
        } else {
            XB_SPIN(xb_ld(&bar[XB_XGEN(b.x)]) == gen, bar);
            __builtin_amdgcn_fence(__ATOMIC_ACQUIRE, "agent");
            asm volatile("s_waitcnt vmcnt(0)" ::: "memory");
        }
    }
    __syncthreads();
}

#ifndef PHASE_SEQ
#define PHASE_SEQ 0, 1, 2, 3, 4, 5, 6, 7, 8, 9, 10, 11, 12, 13, 14, 15, 16, 17, 18, 19, 20
#endif
constexpr int SEQ_HOST[] = {PHASE_SEQ};
constexpr int NPHASE = sizeof(SEQ_HOST) / sizeof(int);
__device__ __forceinline__ int SEQ_AT(int si) { constexpr int t[] = {PHASE_SEQ}; int r = t[0];
#pragma unroll
    for (int i = 1; i < NPHASE; ++i) r = (si == i) ? t[i] : r;
    return r; }
__global__ void __launch_bounds__(NTHR, 2) fwd_kernel(Params p) {
    extern __shared__ __attribute__((aligned(16))) unsigned char shm[];
    LAS unsigned char* lds = (LAS unsigned char*)shm;
    cg::grid_group grid = cg::this_grid();
    __shared__ uint4 xb_words;
    if (threadIdx.x == 0) xb_words = make_uint4(0u, 0u, 0u, 0u);
    __syncthreads();
    XcdBarrier xbar = xcd_barrier_post((unsigned*)(LP(ws) + WS_BAR), (volatile LAS unsigned*)&xb_words);
    const int lo = p.ph_lo, hi = p.ph_hi, G = gridDim.x;
    enum { K_PREP, K_FFN_IN, K_RES, K_HGRN_IN, K_GLA1, K_GLA2, K_GLA3, K_RG_IN, K_CONV, K_GATE, K_SCAN1, K_SCAN3, K_FINAL };
    for (int si = lo; si < hi; ++si) {
        if (si > lo) { if (si == lo + 1) grid.sync(); else xcd_barrier(xbar); }
        int ph = SEQ_AT(si); const bool dup = ph >= 100; if (dup) ph -= 100;
        unsigned char* ws = LP(ws); float* outp = LP(out);
        float* part0 = (float*)(ws + WS_PART); float* part1 = (float*)(ws + WS_PART + SZ_PART);
        float* htail = (float*)(ws + WS_HTAIL); bf16_t* hb = (bf16_t*)(ws + WS_HB);
        const float* oml = (const float*)(ws + WS_VEC); const float* sp = oml + 1024;
        int kind = K_PREP, widx = 0, KK = D; float* pin = part0; float* pout = part1; const bf16_t* Ap = hb; const bf16_t* Wp = nullptr; float sc = 1.0f;
        switch (ph) {
            case 0: kind = K_PREP; break;
            case 1: kind = K_FFN_IN; widx = 0; pin = part0; break;
            case 2: kind = K_RES; Ap = (const bf16_t*)(ws + SC_U); Wp = (const bf16_t*)(ws + W_FFN_OUT + 0 * SZ_FFN_OUT); KK = DFF; pout = part1; sc = 0.5f; break;
            case 3: kind = K_HGRN_IN; pin = part1; break;
            case 4: kind = K_GLA1; break;
            case 5: kind = K_GLA2; break;
            case 6: kind = K_GLA3; break;
            case 7: kind = K_RES; Ap = (const bf16_t*)(ws + SC_G); Wp = (const bf16_t*)(ws + W_A_OUT); KK = D; pout = part0; sc = 1.0f; break;
            case 8: kind = K_FFN_IN; widx = 1; pin = part0; break;
            case 9: kind = K_RES; Ap = (const bf16_t*)(ws + SC_U); Wp = (const bf16_t*)(ws + W_FFN_OUT + 1 * SZ_FFN_OUT); KK = DFF; pout = part1; sc = 0.5f; break;
            case 10: kind = K_FFN_IN; widx = 2; pin = part1; break;
            case 11: kind = K_RES; Ap = (const bf16_t*)(ws + SC_U); Wp = (const bf16_t*)(ws + W_FFN_OUT + 2 * SZ_FFN_OUT); KK = DFF; pout = part0; sc = 0.5f; break;
            case 12: kind = K_RG_IN; pin = part0; break;
            case 13: kind = K_CONV; break;
            case 14: kind = K_GATE; break;
            case 15: kind = K_SCAN1; break;
            case 16: kind = K_SCAN3; break;
            case 17: kind = K_RES; Ap = (const bf16_t*)(ws + SC_GG); Wp = (const bf16_t*)(ws + W_B_OUT); KK = D; pout = part1; sc = 1.0f; break;
            case 18: kind = K_FFN_IN; widx = 3; pin = part1; break;
            case 19: kind = K_RES; Ap = (const bf16_t*)(ws + SC_U); Wp = (const bf16_t*)(ws + W_FFN_OUT + 3 * SZ_FFN_OUT); KK = DFF; pout = part0; sc = 0.5f; break;
            default: kind = K_FINAL; pin = part0; break;
        }
        if (kind == K_PREP) phase_prep(lds);
        else if (kind == K_FFN_IN || kind == K_RES) {
            const bool fold = (G == 256);
            const int cb = obid();
            bool tail_unit = false;
            if (kind == K_FFN_IN) {
                unsigned* tcnt = (unsigned*)(ws + WS_BAR) + 3584 + 128 * widx;
                pg8::Gemm g{hb, (const bf16_t*)(ws + W_FFN_IN + (size_t)widx * SZ_FFN_IN), D, D, D, MP / 256, 2 * DFF / 256}; pg8::StaticOrder S; S.init(g.nM, g.nN, G, cb); if (fold) S.mode = 1;
                EpiFfnIn E{(bf16_t*)(ws + SC_U), pin, fold ? tcnt : nullptr}; pg8::gemm_phase<EpiFfnIn, false>(lds, g, S, E);
                if (fold && cb >= 248) {
                    const int tpm = (cb - 248) >> 2;
                    if (otid() < 64) { unsigned spins = 0;
                        while ((unsigned)__builtin_amdgcn_readfirstlane(__hip_atomic_load(tcnt + 64 * tpm, __ATOMIC_RELAXED, __HIP_MEMORY_SCOPE_AGENT)) < 176u) { __builtin_amdgcn_s_sleep(4); if (++spins > (1u << 22)) break; }
                        __builtin_amdgcn_fence(__ATOMIC_ACQUIRE, "agent"); asm volatile("s_waitcnt vmcnt(0)" ::: "memory"); }
                    __syncthreads();
                    tail_unit = true; Ap = (const bf16_t*)(ws + SC_U); Wp = (const bf16_t*)(ws + W_FFN_OUT + (size_t)widx * SZ_FFN_OUT); KK = DFF; pout = (pin == part0) ? part1 : part0; sc = 0.5f;
                }
            }
            if (kind == K_RES || tail_unit) {
                const bool ffn_out = (KK == DFF);
                pg8::Gemm g{Ap, Wp, KK, KK, KK, (fold && ffn_out) ? 128 : MP / 256, D / 256}; pg8::StaticOrder S; S.init(g.nM, g.nN, G, cb);
                if (tail_unit) { S.mode = 2; S.spm = 128 + ((cb - 248) >> 2); S.spn = (cb - 248) & 3; }
                const int first_res = (!dup && (ph == 2 || (tail_unit && widx == 0))) ? 1 : 0;
                EpiRes E{outp, htail, hb, pout, dup ? 0.0f : sc, LP(x_prompt), LP(x_sample), LP(meta), first_res}; pg8::gemm_phase<EpiRes, false>(lds, g, S, E);
            }
        }
        else if (kind == K_HGRN_IN) { pg8::Gemm g{hb, (const bf16_t*)(ws + W_A_IN), D, D, D, MP / 256, 16}; pg8::StaticOrder S; S.init(g.nM, g.nN, G, obid());
            EpiHgrnIn E{(bf16_t*)(ws + SC_Q), (bf16_t*)(ws + SC_K), (bf16_t*)(ws + SC_V), (bf16_t*)(ws + SC_G), pin, oml}; pg8::gemm_phase<EpiHgrnIn, false>(lds, g, S, E); }
        else if (kind == K_GLA1) phase_gla1(lds);
        else if (kind == K_GLA2) phase_gla2();
        else if (kind == K_GLA3) phase_gla3(lds);
        else if (kind == K_RG_IN) { pg8::Gemm g{hb, (const bf16_t*)(ws + W_B_IN), D, D, D, MP / 256, 8}; pg8::StaticOrder S; S.init(g.nM, g.nN, G, obid());
            EpiRgIn E{(bf16_t*)(ws + SC_XB), (bf16_t*)(ws + SC_GG), pin, outp + O_CP, outp + O_CS}; pg8::gemm_phase<EpiRgIn, false>(lds, g, S, E); }
        else if (kind == K_CONV) phase_conv();
        else if (kind == K_GATE) { int kg = 128; asm volatile("" : "+s"(kg)); pg8::Gemm g{(const bf16_t*)(ws + SC_CF), (const bf16_t*)(ws + W_G), D, kg, kg, MP / 256, 8}; pg8::StaticOrder S; S.init(g.nM, g.nN, G, obid());
            EpiGate E{nullptr, (const bf16_t*)(ws + SC_CF), (bf16_t*)(ws + SC_OM), (bf16_t*)(ws + SC_UU), LP(b_ba), LP(b_bx), sp}; pg8::gemm_phase<EpiGate, true>(lds, g, S, E); }
        else if (kind == K_SCAN1) phase_scan1();
        else if (kind == K_SCAN3) phase_scan3();
        else phase_final(pin);
    }
}

extern "C" void kernel_launch(void* const* d_in, const int* in_sizes, int n_in, void* d_out, int out_size, void* d_ws, size_t ws_size, hipStream_t stream) {
    static int grid = 0;
    constexpr int LDS_BYTES = pg8::STAGE_BYTES + 16384;
    if (grid == 0) {
        if (n_in != 24 || ws_size < WS_TOTAL) { fprintf(stderr, "kernel_launch: unexpected n_in %d or workspace %zu < %zu\n", n_in, ws_size, (size_t)WS_TOTAL); grid = -1; return; }
        if (hipFuncSetAttribute((const void*)fwd_kernel, hipFuncAttributeMaxDynamicSharedMemorySize, LDS_BYTES) != hipSuccess) { fprintf(stderr, "kernel_launch: hipFuncSetAttribute failed\n"); grid = -1; return; }
        int dev = 0, cus = 0, per_cu = 0;
        hipGetDevice(&dev); hipDeviceGetAttribute(&cus, hipDeviceAttributeMultiprocessorCount, dev);
        hipOccupancyMaxActiveBlocksPerMultiprocessor(&per_cu, (const void*)fwd_kernel, NTHR, LDS_BYTES);
        if (per_cu < 1) { fprintf(stderr, "kernel_launch: occupancy query says %d blocks per CU\n", per_cu); per_cu = 1; }
        (void)hipGetLastError();
        grid = cus;
    }
    if (grid < 0) return;
    Params p{};
    const float** f = (const float**)&p;
    for (int i = 0; i < 24; ++i) f[i] = (const float*)d_in[i];
    p.out = (float*)d_out; p.ws = (unsigned char*)d_ws;
#if MK_FUSED
    if (hipMemsetAsync((char*)d_ws + WS_BAR, 0, 16384 + 65536, stream) != hipSuccess) { fprintf(stderr, "kernel_launch: hipMemsetAsync failed\n"); return; }
    p.ph_lo = 0; p.ph_hi = NPHASE;
    void* args[] = {&p};
    hipError_t e = hipLaunchCooperativeKernel((const void*)fwd_kernel, dim3(grid), dim3(NTHR), args, LDS_BYTES, stream);
    if (e != hipSuccess) fprintf(stderr, "cooperative launch failed: %s (grid %d)\n", hipGetErrorString(e), grid);
#else
    for (int k = 0; k < NPHASE; ++k) { p.ph_lo = k; p.ph_hi = k + 1; hipLaunchKernelGGL(fwd_kernel, dim3(grid), dim3(NTHR), LDS_BYTES, stream, p); }
#endif
}
```

```cpp
#include <hip/hip_runtime.h>
#include <hip/hip_cooperative_groups.h>
#include <cstdio>
#include <cstddef>
namespace cg = cooperative_groups;

#ifndef PHASE_MASK
#define PHASE_MASK 0x1FFFFF
#endif
#ifndef MK_FUSED
#define MK_FUSED 1
#endif

#define LAS __attribute__((address_space(3)))
typedef unsigned short bf16_t;
typedef short bf16x8 __attribute__((ext_vector_type(8)));
typedef float f32x4 __attribute__((ext_vector_type(4)));
typedef float f32x2 __attribute__((ext_vector_type(2)));
typedef unsigned u32x4 __attribute__((ext_vector_type(4)));
typedef unsigned u32x2 __attribute__((ext_vector_type(2)));

constexpr int D = 1024, DFF = 2816, NTHR = 512;
constexpr int MP = 33280;
constexpr int ROW_SAMPLE = 32768;
constexpr int ROW_META = 33024;
constexpr int ROW_PAD = 33088;
constexpr int NCH = 33;
constexpr int RCH = 129;
constexpr float EPS = 1e-6f;

constexpr size_t O_YP = 0, O_YS = 33554432, O_HP = 33816576, O_HS = O_HP + 524288, O_RP = O_HS + 2097152, O_RS = O_RP + 4096,
                 O_CP = O_RS + 16384, O_CS = O_CP + 12288;
constexpr size_t SZ_ACT = (size_t)MP * D * 2;
constexpr size_t W_FFN_IN = 0, SZ_FFN_IN = (size_t)2 * DFF * D * 2;
constexpr size_t W_FFN_OUT = W_FFN_IN + 4 * SZ_FFN_IN, SZ_FFN_OUT = (size_t)D * DFF * 2;
constexpr size_t W_A_IN = W_FFN_OUT + 4 * SZ_FFN_OUT;
constexpr size_t W_A_OUT = W_A_IN + (size_t)4096 * D * 2;
constexpr size_t W_B_IN = W_A_OUT + (size_t)D * D * 2;
constexpr size_t W_B_OUT = W_B_IN + (size_t)2048 * D * 2;
constexpr size_t W_G = W_B_OUT + (size_t)D * D * 2;
constexpr size_t WS_VEC = W_G + (size_t)8 * 256 * 256 * 2;
constexpr size_t WS_HB = WS_VEC + 8192;
constexpr size_t WS_PART = WS_HB + SZ_ACT, SZ_PART = (size_t)MP * 16 * 4;
constexpr size_t WS_HTAIL = WS_PART + 2 * SZ_PART;
constexpr size_t WS_SCR = WS_HTAIL + (size_t)256 * D * 4;
constexpr size_t SC_U = WS_SCR;
constexpr size_t SC_Q = WS_SCR, SC_K = SC_Q + SZ_ACT, SC_V = SC_K + SZ_ACT, SC_G = SC_V + SZ_ACT, SC_SST = SC_G + SZ_ACT,
                 SC_DC = SC_SST + (size_t)4 * 8 * NCH * 16384 * 4, SC_END1 = SC_DC + (size_t)4 * 8 * NCH * 128 * 4;
constexpr size_t SC_XB = WS_SCR, SC_GG = SC_XB + SZ_ACT, SC_CF = SC_GG + SZ_ACT, SC_OM = SC_CF + SZ_ACT, SC_UU = SC_OM + SZ_ACT,
                 SC_AB = SC_UU + SZ_ACT, SC_END2 = SC_AB + (size_t)4 * RCH * 1024 * 2 * 4;
constexpr size_t WS_END = (SC_END1 > SC_END2 ? SC_END1 : SC_END2);
static_assert((size_t)MP * DFF * 2 <= SC_END1 - WS_SCR, "U fits");
constexpr size_t WS_BAR = (WS_END + 255) / 256 * 256, WS_ZERO = WS_BAR + 16384, WS_TOTAL = WS_ZERO + 65536;
static_assert(WS_TOTAL <= (size_t)536870912, "workspace budget");

struct Params {
    const float *x_prompt, *x_sample, *state_hgrn, *state_rglru, *state_conv, *meta, *ffn_norm, *ffn_w_in, *ffn_w_out, *mix_norm,
        *a_w_in, *a_lb, *a_onorm, *a_w_out, *b_w_in, *b_conv_w, *b_conv_b, *b_wa, *b_ba, *b_wx, *b_bx, *b_lambda, *b_w_out, *final_norm;
    float* out; unsigned char* ws; int ph_lo, ph_hi;
};

typedef __bf16 bf16x2v_ __attribute__((ext_vector_type(2)));
__device__ __forceinline__ unsigned cvt_pk_bf16(float lo, float hi) { const f32x2 v = {lo, hi}; return __builtin_bit_cast(unsigned, __builtin_convertvector(v, bf16x2v_)); }
__device__ __forceinline__ float bf_lo(unsigned w) { return __uint_as_float(w << 16); }
__device__ __forceinline__ float bf_hi(unsigned w) { return __uint_as_float(w & 0xffff0000u); }
__device__ __forceinline__ float bf2f(bf16_t b) { return __uint_as_float(((unsigned)b) << 16); }
__device__ __forceinline__ float sigmoidf_(float x) { return __builtin_amdgcn_rcpf(1.0f + __expf(-x)); }
__device__ __forceinline__ float siluf_(float x) { return x * sigmoidf_(x); }
__device__ __forceinline__ float gelu_tanh(float x) { const float t = 1.5957691216f * (x + 0.044715f * x * x * x); return x * sigmoidf_(t); }
__device__ __forceinline__ float* hrow(float* hmain, float* htail, int row) { return row < ROW_META ? hmain + (size_t)row * D : htail + (size_t)(row - ROW_META) * D; }
#define GASP __attribute__((address_space(1)))
__device__ __forceinline__ void gst16(void* p, u32x4 v) { *(GASP u32x4*)(GASP void*)p = v; }
__device__ __forceinline__ void gst8u(void* p, u32x2 v) { *(GASP u32x2*)(GASP void*)p = v; }
__device__ __forceinline__ void gst16f(void* p, f32x4 v) { *(GASP f32x4*)(GASP void*)p = v; }
__device__ __forceinline__ f32x4 gld16f(const void* p) { return *(const GASP f32x4*)(const GASP void*)p; }
__device__ __forceinline__ float* hrow2(float* hmain, float* htail, int row) {
    const long long d = (long long)((const char*)htail - (const char*)hmain) - (long long)ROW_META * D * 4;
    return (float*)((char*)hmain + (size_t)row * D * 4 + (row >= ROW_META ? d : 0ll)); }

__device__ __forceinline__ unsigned long long karg(int i) { const __attribute__((address_space(4))) unsigned long long* ka = (const __attribute__((address_space(4))) unsigned long long*)__builtin_amdgcn_kernarg_segment_ptr(); asm volatile("" : "+s"(ka)); return ka[i]; }
#define LP(f) ((decltype(Params::f))karg((int)(offsetof(Params, f) / 8)))
#define LOADP(f) p.f = LP(f)
__device__ __forceinline__ float shx(float v, int o, int lane) { return __int_as_float(__builtin_amdgcn_ds_bpermute((lane ^ o) << 2, __float_as_int(v))); }
__device__ __forceinline__ int otid() { int t = threadIdx.x; asm volatile("" : "+v"(t)); return t; }
__device__ __forceinline__ int obid() { int b = blockIdx.x; asm volatile("" : "+s"(b)); return b; }
namespace pg8 {
constexpr int BM = 256, BK = 64, HALF = 128, HTB = HALF * BK * 2, STAGE_BYTES = 8 * HTB, NXCD = 8, WGM = 8;
__host__ __device__ __forceinline__ int lds_byte(int r, int c) { const int st = (r >> 4) * 2 + (c >> 5), rr = r & 15, cc = c & 31, ob = rr * 64 + cc * 2; return st * 1024 + (ob ^ (((ob >> 9) & 1) << 5)); }
__host__ __device__ __forceinline__ void stage_rc(int b, int& R, int& C) { const int st = b / 1024, sb = b % 1024, swz = sb ^ (((sb >> 9) & 1) << 5); R = (st >> 1) * 16 + swz / 64; C = (st & 1) * 32 + (swz % 64) / 2; }
__host__ __device__ __forceinline__ int perm32(int rho) { const int n = rho >> 4, i = rho & 15; return 8 * (i >> 2) + 4 * n + (i & 3); }
struct Unit { int pm, pn; };
struct Gemm { const bf16_t* A; const bf16_t* Bt; int lda, ldb, K, nM, nN; };
struct StaticOrder {
    int nM, nN, nwg, G, c, mode, spm, spn;
    __device__ void init(int nM_, int nN_, int G_, int c_) { nM = nM_; nN = nN_; nwg = nM * nN; G = G_; c = c_; mode = 0; spm = 0; spn = 0; }
    __device__ bool next(int i, Unit& u) const {
        if (mode == 2) { if (i > 0) return false; u.pm = spm; u.pn = spn; return true; }
        long L;
        if (mode == 1) {
            if (c >= 248) { if (i >= 9) return false; L = (long)i * 256 + c; }
            else if (c >= 44 && c < 60) { if (i < 11) L = (long)i * 256 + c; else if (i == 11) L = 2304 + 256 * ((c - 44) >> 3) + 248 + ((c - 44) & 7); else return false; }
            else { L = (long)i * 256 + c; if (L >= 2860) return false; }
            if (L < 44) { u.pm = 128 + ((int)L & 1); u.pn = (int)L >> 1; return true; }
            L -= 44;
            int wgid = (int)L; { const int q = 2816 / NXCD, xcd = wgid % NXCD, off = wgid / NXCD; wgid = xcd * q + off; }
            const int nig = WGM * 22, gid = wgid / nig; u.pm = gid * WGM + ((wgid % nig) % WGM); u.pn = (wgid % nig) / WGM; return true;
        }
        L = (long)i * G + c; if (L >= nwg) return false;
        int wgid = (int)L; { const int q = nwg / NXCD, r = nwg % NXCD, xcd = wgid % NXCD, off = wgid / NXCD; wgid = (xcd < r ? xcd * (q + 1) : r * (q + 1) + (xcd - r) * q) + off; }
        const int nig = WGM * nN, gid = wgid / nig, fm = gid * WGM, gsz = (nM - fm) < WGM ? (nM - fm) : WGM;
        u.pm = fm + ((wgid % nig) % gsz); u.pn = (wgid % nig) / gsz; return true;
    }
};

template <class Epi, bool AKOFF>
__device__ __forceinline__ void gemm_phase(LAS unsigned char* lds, const Gemm g, const StaticOrder& S, const Epi& E) {
    int tid_ = otid();
    const int tid = tid_, wid = __builtin_amdgcn_readfirstlane(tid >> 6), lane = tid & 63, wr = wid >> 2, wc = wid & 3, fr = lane & 15, fq = lane >> 4;
    const int K = g.K, nt = K / BK;
    unsigned voffA[2], voffB[2];
#pragma unroll
    for (int i = 0; i < 2; ++i) { int R, C; stage_rc(tid * 16 + i * 8192, R, C); const int Rb = Epi::PERM ? ((R & ~31) + perm32(R & 31)) : R;
        voffA[i] = (unsigned)(R * g.lda + C) * 2u; voffB[i] = (unsigned)(Rb * g.ldb + C) * 2u; }
    const size_t kstep = (size_t)(BK * 2);
    const size_t hstepA = (size_t)HALF * g.lda * 2, hstepB = (size_t)HALF * g.ldb * 2;
    const unsigned ldsw = (unsigned)wid * 1024u;
    const int aoff = lds_byte(wr * 64 + fr, fq * 8), boff = lds_byte(wc * 32 + fr, fq * 8);
#define PG8_SA(b, h) (((b) * 2 + (h)) * HTB)
#define PG8_SB(b, h) ((4 + (b) * 2 + (h)) * HTB)
#define PG8_STAGE(bufoff, gbase, voff) do { _Pragma("unroll") for (int _i = 0; _i < 2; ++_i) \
        __builtin_amdgcn_global_load_lds((const unsigned*)((const char*)(gbase) + (voff)[_i]), (LAS unsigned*)(lds + (bufoff) + ldsw + _i * 8192), 16, 0, 0); } while (0)
#define PG8_LDA(dst, b, h) do { _Pragma("unroll") for (int m = 0; m < 4; ++m) _Pragma("unroll") for (int k = 0; k < 2; ++k) dst[m][k] = *(const LAS bf16x8*)(lds + PG8_SA(b, h) + aoff + m * 2048 + k * 1024); } while (0)
#define PG8_LDB(dst, b, h) do { _Pragma("unroll") for (int n = 0; n < 2; ++n) _Pragma("unroll") for (int k = 0; k < 2; ++k) dst[n][k] = *(const LAS bf16x8*)(lds + PG8_SB(b, h) + boff + n * 2048 + k * 1024); } while (0)
#define PG8_MMA(ai, bj, At, Bt) do { __builtin_amdgcn_s_setprio(1); _Pragma("unroll") for (int m = 0; m < 4; ++m) _Pragma("unroll") for (int n = 0; n < 2; ++n) _Pragma("unroll") for (int k = 0; k < 2; ++k) \
        acc[ai][bj][m][n] = __builtin_amdgcn_mfma_f32_16x16x32_bf16(Bt[n][k], At[m][k], acc[ai][bj][m][n], 0, 0, 0); __builtin_amdgcn_s_setprio(0); } while (0)
#define PG8_WAIT_V(n) asm volatile("s_waitcnt vmcnt(" #n ")" ::: "memory")
#define PG8_WAIT_L(n) asm volatile("s_waitcnt lgkmcnt(" #n ")" ::: "memory")
#define PG8_BAR __builtin_amdgcn_s_barrier()
#define PG8_SCHED __builtin_amdgcn_sched_barrier(0)
#define PG8_UA(u) ((const char*)g.A + ((size_t)(u).pm * BM * g.lda + (AKOFF ? (size_t)128 * (u).pn : (size_t)0)) * 2)
#define PG8_UB(u) ((const char*)g.Bt + (size_t)(u).pn * BM * g.ldb * 2)
    Unit cur, nxt; int ui = 0;
    if (!S.next(0, cur)) return;
    f32x4 acc[2][2][4][2];
#pragma unroll
    for (int a = 0; a < 2; ++a)
#pragma unroll
        for (int b = 0; b < 2; ++b)
#pragma unroll
            for (int m = 0; m < 4; ++m)
#pragma unroll
                for (int n = 0; n < 2; ++n) acc[a][b][m][n] = (f32x4){0.f, 0.f, 0.f, 0.f};
    bf16x8 At[4][2], B0[2][2], B1[2][2];
    const char* cA = PG8_UA(cur); const char* cB = PG8_UB(cur);
    PG8_STAGE(PG8_SB(0, 0), cB, voffB); PG8_STAGE(PG8_SA(0, 0), cA, voffA); PG8_STAGE(PG8_SB(0, 1), cB + hstepB, voffB); PG8_STAGE(PG8_SA(0, 1), cA + hstepA, voffA);
    if (wr == 1) PG8_BAR;
    PG8_WAIT_V(4); PG8_BAR;
    PG8_STAGE(PG8_SB(1, 0), cB + kstep, voffB); PG8_STAGE(PG8_SA(1, 0), cA + kstep, voffA); PG8_STAGE(PG8_SB(1, 1), cB + hstepB + kstep, voffB);
    PG8_WAIT_V(6); PG8_BAR;
    for (;;) {
        if (Epi::PARTPF) {
            if (ui > 0) { PG8_BAR; PG8_BAR; }
            unsigned pvo = (unsigned)(tid & 63) * 16u + (unsigned)wid * 2048u; asm volatile("" : "+v"(pvo));
            const char* psrc = (const char*)E.part + (size_t)cur.pm * (256 * 64);
            _Pragma("unroll") for (int _i = 0; _i < 2; ++_i)
                __builtin_amdgcn_global_load_lds((const unsigned*)(psrc + pvo + _i * 1024), (LAS unsigned*)(lds + STAGE_BYTES + wid * 2048 + _i * 1024), 16, 0, 0);
        }
        const bool has_next = S.next(ui + 1, nxt);
        const char* nA = has_next ? PG8_UA(nxt) : cA; const char* nB = has_next ? PG8_UB(nxt) : cB;
        for (int t = 0; t < nt; t += 2) {
            const bool last = (t == nt - 2);
            const char* a1 = cA + (size_t)(t + 1) * kstep;
            const char* a2 = last ? nA : cA + (size_t)(t + 2) * kstep; const char* b2 = last ? nB : cB + (size_t)(t + 2) * kstep;
            const char* a3 = a2 + kstep; const char* b3 = b2 + kstep;
            PG8_LDB(B0, 0, 0); PG8_SCHED; PG8_LDA(At, 0, 0); PG8_STAGE(PG8_SA(1, 1), a1 + hstepA, voffA);
            PG8_WAIT_L(8); PG8_BAR; PG8_WAIT_L(0); PG8_MMA(0, 0, At, B0); PG8_BAR; PG8_SCHED;
            PG8_LDB(B1, 0, 1); PG8_STAGE(PG8_SB(0, 0), b2, voffB);
            PG8_BAR; PG8_WAIT_L(0); PG8_MMA(0, 1, At, B1); PG8_BAR;
            PG8_LDA(At, 0, 1); PG8_STAGE(PG8_SA(0, 0), a2, voffA);
            PG8_BAR; PG8_WAIT_L(0); PG8_MMA(1, 0, At, B0); PG8_BAR; PG8_SCHED;
            PG8_STAGE(PG8_SB(0, 1), b2 + hstepB, voffB);
            PG8_WAIT_V(6); PG8_BAR; PG8_MMA(1, 1, At, B1); PG8_BAR;
            PG8_LDB(B0, 1, 0); PG8_SCHED; PG8_LDA(At, 1, 0); PG8_STAGE(PG8_SA(0, 1), a2 + hstepA, voffA);
            PG8_WAIT_L(8); PG8_BAR; PG8_WAIT_L(0); PG8_MMA(0, 0, At, B0); PG8_BAR; PG8_SCHED;
            PG8_LDB(B1, 1, 1); PG8_STAGE(PG8_SB(1, 0), b3, voffB);
            PG8_BAR; PG8_WAIT_L(0); PG8_MMA(0, 1, At, B1); PG8_BAR;
            PG8_LDA(At, 1, 1); PG8_STAGE(PG8_SA(1, 0), a3, voffA);
            PG8_BAR; PG8_WAIT_L(0); PG8_MMA(1, 0, At, B0); PG8_BAR; PG8_SCHED;
            PG8_STAGE(PG8_SB(1, 1), b3 + hstepB, voffB);
            PG8_WAIT_V(6); PG8_BAR; PG8_MMA(1, 1, At, B1); PG8_BAR;
        }
        E(acc, cur, wr, wc, fr, fq, lds);
        if (!has_next) break;
#pragma unroll
        for (int a = 0; a < 2; ++a)
#pragma unroll
            for (int b = 0; b < 2; ++b)
#pragma unroll
                for (int m = 0; m < 4; ++m)
#pragma unroll
                    for (int n = 0; n < 2; ++n) { f32x2 z0, z1; asm volatile("v_mov_b64 %0, 0\n\tv_mov_b64 %1, 0" : "=v"(z0), "=v"(z1)); acc[a][b][m][n] = (f32x4){z0[0], z0[1], z1[0], z1[1]}; }
        cur = nxt; cA = nA; cB = nB; ++ui;
    }
    PG8_WAIT_V(0);
    if (wr == 0) PG8_BAR;
    PG8_BAR;
#undef PG8_SA
#undef PG8_SB
#undef PG8_STAGE
#undef PG8_LDA
#undef PG8_LDB
#undef PG8_MMA
#undef PG8_WAIT_V
#undef PG8_WAIT_L
#undef PG8_BAR
#undef PG8_SCHED
#undef PG8_UA
#undef PG8_UB
}
}
using pg8::Unit;
typedef f32x4 Acc[2][2][4][2];

__device__ __forceinline__ float row_rstd(const float* part, int row, int fr, int fq) {
    const f32x4 p = *(const f32x4*)(part + (size_t)row * 16 + 4 * fq);
    float s = (p[0] + p[1]) + (p[2] + p[3]);
    const int lane = (fq << 4) | fr; s += shx(s, 16, lane); s += shx(s, 32, lane);
    return rsqrtf(s * (1.0f / 1024.0f) + EPS);
}

__device__ __forceinline__ void rows_rstd8_lds(const LAS unsigned char* pl, int rl0, int fr, int fq, float (&rs)[8]) {
    float mine[2];
#pragma unroll
    for (int k = 0; k < 2; ++k) {
        const int r = 2 * fq + k; const LAS unsigned char* rp = pl + (rl0 + (r >> 2) * 128 + (r & 3) * 16) * 64;
        const f32x4 p0 = *(const LAS f32x4*)(rp), p1 = *(const LAS f32x4*)(rp + 16), p2 = *(const LAS f32x4*)(rp + 32), p3 = *(const LAS f32x4*)(rp + 48);
        const f32x4 q = (p0 + p1) + (p2 + p3);
        mine[k] = __builtin_amdgcn_rsqf(((q[0] + q[1]) + (q[2] + q[3])) * (1.0f / 1024.0f) + EPS);
    }
#pragma unroll
    for (int q = 0; q < 4; ++q) {
        rs[2 * q] = __int_as_float(__builtin_amdgcn_ds_bpermute(((q << 4) | fr) << 2, __float_as_int(mine[0])));
        rs[2 * q + 1] = __int_as_float(__builtin_amdgcn_ds_bpermute(((q << 4) | fr) << 2, __float_as_int(mine[1])));
    }
}
__device__ __forceinline__ void rows_rstd8(const float* part, int row0, int fr, int fq, float (&rs)[8]) {
    f32x4 pv[8];
#pragma unroll
    for (int r = 0; r < 8; ++r) pv[r] = *(const f32x4*)(part + (size_t)(row0 + (r >> 2) * 128 + (r & 3) * 16) * 16 + 4 * fq);
    const int lane = (fq << 4) | fr;
#pragma unroll
    for (int r = 0; r < 8; ++r) { float s_ = (pv[r][0] + pv[r][1]) + (pv[r][2] + pv[r][3]); s_ += shx(s_, 16, lane); s_ += shx(s_, 32, lane); rs[r] = rsqrtf(s_ * (1.0f / 1024.0f) + EPS); }
}
struct EpiFfnIn {
    static constexpr bool PERM = true, PARTPF = true;
    bf16_t* U; const float* part; unsigned* cnt;
    __device__ __forceinline__ void operator()(const Acc& acc, const Unit& u, int wr, int wc, int fr, int fq, LAS unsigned char* lds) const {
        const int row0 = u.pm * 256 + wr * 64 + fr, col0 = u.pn * 128 + wc * 32 + 8 * fq;
        float rsv[8]; rows_rstd8_lds(lds + pg8::STAGE_BYTES, wr * 64 + fr, fr, fq, rsv);
#pragma unroll
        for (int ai = 0; ai < 2; ++ai)
#pragma unroll
            for (int m = 0; m < 4; ++m) {
                const int row = row0 + ai * 128 + m * 16; const float rs = rsv[ai * 4 + m];
                const float rsn = rs * -1.4426950409f, rs2 = rs * rs; unsigned wv[4];
#pragma unroll
                for (int n = 0; n < 2; ++n)
#pragma unroll
                    for (int e2 = 0; e2 < 2; ++e2) {
                        const f32x2 a = {acc[ai][0][m][n][2 * e2], acc[ai][0][m][n][2 * e2 + 1]}, b = {acc[ai][1][m][n][2 * e2], acc[ai][1][m][n][2 * e2 + 1]};
                        const f32x2 arg = a * rsn;
                        f32x2 d; d.x = __builtin_amdgcn_exp2f(arg.x); d.y = __builtin_amdgcn_exp2f(arg.y); d = d + 1.0f;
                        f32x2 r; r.x = __builtin_amdgcn_rcpf(d.x); r.y = __builtin_amdgcn_rcpf(d.y);
                        const f32x2 o2 = ((a * b) * r) * rs2;
                        wv[n * 2 + e2] = cvt_pk_bf16(o2.x, o2.y); }
                u32x4 w; w.x = wv[0]; w.y = wv[1]; w.z = wv[2]; w.w = wv[3];
                gst16(U + (size_t)row * DFF + col0, w);
            }
        if (cnt && u.pm >= 128) {
            asm volatile("s_waitcnt vmcnt(0)" ::: "memory");
            __builtin_amdgcn_fence(__ATOMIC_RELEASE, "agent");
            asm volatile("s_waitcnt vmcnt(0)" ::: "memory");
            if (fr == 0 && fq == 0) __hip_atomic_fetch_add(cnt + 64 * (u.pm - 128), 1u, __ATOMIC_RELAXED, __HIP_MEMORY_SCOPE_AGENT);
        }
    }
};
struct EpiRes {
    static constexpr bool PERM = true, PARTPF = false;
    float* hmain; float* htail; bf16_t* hb; float* part; float scale; const float *xp, *xs, *xm; int first;
    __device__ __forceinline__ const float* rsrc(int row) const {
        if (!first) return hrow2(hmain, htail, row);
        const char* b0 = (const char*)xp + (size_t)row * (D * 4);
        const char* b1 = (const char*)xs + (size_t)(row - ROW_SAMPLE) * (D * 4);
        const char* b2 = (const char*)xm + (size_t)((row - ROW_META) & 15) * (D * 4);
        return (const float*)(row < ROW_SAMPLE ? b0 : (row < ROW_META ? b1 : b2));
    }
    __device__ __forceinline__ void operator()(const Acc& acc, const Unit& u, int wr, int wc, int fr, int fq, LAS unsigned char* lds) const {
        const int row0 = u.pm * 256 + wr * 64 + fr, col0 = u.pn * 256 + wc * 32 + 8 * fq, lane = (fq << 4) | fr;
#pragma unroll
        for (int ai = 0; ai < 2; ++ai) {
            f32x4 x[4][2][2];
#pragma unroll
            for (int m = 0; m < 4; ++m) { const int rr = row0 + ai * 128 + m * 16; const float* hp = rsrc(rr) + col0; const float keep = (first && rr >= ROW_PAD) ? 0.f : 1.f;
#pragma unroll
                for (int bj = 0; bj < 2; ++bj)
#pragma unroll
                    for (int n = 0; n < 2; ++n) x[m][bj][n] = gld16f(hp + bj * 128 + n * 4) * keep; }
#pragma unroll
            for (int m = 0; m < 4; ++m) {
                const int row = row0 + ai * 128 + m * 16; float* hp = hrow2(hmain, htail, row) + col0; bf16_t* bp = hb + (size_t)row * D + col0; float ss = 0.f;
#pragma unroll
                for (int bj = 0; bj < 2; ++bj) {
                    const f32x4 v0 = x[m][bj][0] + acc[ai][bj][m][0] * scale, v1 = x[m][bj][1] + acc[ai][bj][m][1] * scale;
                    gst16f(hp + bj * 128, v0); gst16f(hp + bj * 128 + 4, v1);
                    ss += ((v0[0] * v0[0] + v0[1] * v0[1]) + (v0[2] * v0[2] + v0[3] * v0[3])) + ((v1[0] * v1[0] + v1[1] * v1[1]) + (v1[2] * v1[2] + v1[3] * v1[3]));
                    u32x4 w; w.x = cvt_pk_bf16(v0[0], v0[1]); w.y = cvt_pk_bf16(v0[2], v0[3]); w.z = cvt_pk_bf16(v1[0], v1[1]); w.w = cvt_pk_bf16(v1[2], v1[3]);
                    gst16(bp + bj * 128, w); }
                ss += shx(ss, 16, lane); ss += shx(ss, 32, lane);
                if (fq == 0) part[(size_t)row * 16 + 4 * u.pn + wc] = ss;
            }
            asm volatile("" ::: "memory");
        }
    }
};
template <int ACT>
__device__ __forceinline__ void inproj_store(const Acc& acc, bf16_t* dst, int row0, int col0, const float (&rsv)[8], const float (&ol)[2][8], float* const (&cdst)[8]) {
#pragma unroll
    for (int ai = 0; ai < 2; ++ai)
#pragma unroll
        for (int m = 0; m < 4; ++m) {
            const int row = row0 + ai * 128 + m * 16; const float rs = rsv[ai * 4 + m];
#pragma unroll
            for (int bj = 0; bj < 2; ++bj) {
                float o[8];
#pragma unroll
                for (int n = 0; n < 2; ++n)
#pragma unroll
                    for (int e2 = 0; e2 < 2; ++e2) {
                        const f32x2 a2 = {acc[ai][bj][m][n][2 * e2], acc[ai][bj][m][n][2 * e2 + 1]}; f32x2 o2;
                        if (ACT == 0) o2 = a2 * rs;
                        else {
                            f32x2 arg, x = a2 * rs;
                            if (ACT == 1) arg = a2 * (rs * -1.4426950409f);
                            else if (ACT == 2) arg = a2 * (rs * 1.4426950409f);
                            else { const f32x2 x2 = x * x; arg = (x * (-1.4426950409f * 1.5957691216f)) * (x2 * 0.044715f + 1.0f); }
                            f32x2 d; d.x = __builtin_amdgcn_exp2f(arg.x); d.y = __builtin_amdgcn_exp2f(arg.y); d = d + 1.0f;
                            f32x2 r; r.x = __builtin_amdgcn_rcpf(d.x); r.y = __builtin_amdgcn_rcpf(d.y);
                            if (ACT == 2) { const f32x2 l2 = {ol[bj][n * 4 + 2 * e2], ol[bj][n * 4 + 2 * e2 + 1]}; o2 = l2 * r; } else o2 = x * r;
                        }
                        o[n * 4 + 2 * e2] = o2.x; o[n * 4 + 2 * e2 + 1] = o2.y; }
                u32x4 w; w.x = cvt_pk_bf16(o[0], o[1]); w.y = cvt_pk_bf16(o[2], o[3]); w.z = cvt_pk_bf16(o[4], o[5]); w.w = cvt_pk_bf16(o[6], o[7]);
                gst16(dst + (size_t)row * D + col0 + bj * 128, w);
                if (ACT == 0 && cdst[ai * 4 + m]) { float* cd = cdst[ai * 4 + m]; gst16f(cd + col0 + bj * 128, (f32x4){o[0], o[1], o[2], o[3]}); gst16f(cd + col0 + bj * 128 + 4, (f32x4){o[4], o[5], o[6], o[7]}); }
            }
        }
}
struct EpiHgrnIn {
    static constexpr bool PERM = true, PARTPF = true;
    bf16_t *Q, *KK, *V, *G; const float* part; const float* oml;
    __device__ __forceinline__ void operator()(const Acc& acc, const Unit& u, int wr, int wc, int fr, int fq, LAS unsigned char* lds) const {
        const int region = u.pn >> 2;
        const int row0 = u.pm * 256 + wr * 64 + fr, col0 = (u.pn & 3) * 256 + wc * 32 + 8 * fq;
        float rsv[8]; rows_rstd8_lds(lds + pg8::STAGE_BYTES, wr * 64 + fr, fr, fq, rsv);
        float ol[2][8]; float* cd[8];
#pragma unroll
        for (int r = 0; r < 8; ++r) { cd[r] = nullptr; ol[0][r] = 0.f; ol[1][r] = 0.f; }
        if (region == 0) inproj_store<1>(acc, Q, row0, col0, rsv, ol, cd);
        else if (region == 1) {
#pragma unroll
            for (int bj = 0; bj < 2; ++bj) { const f32x4 a = *(const f32x4*)(oml + col0 + bj * 128), b = *(const f32x4*)(oml + col0 + bj * 128 + 4);
#pragma unroll
                for (int e = 0; e < 4; ++e) { ol[bj][e] = a[e]; ol[bj][4 + e] = b[e]; } }
            inproj_store<2>(acc, KK, row0, col0, rsv, ol, cd);
        }
        else if (region == 2) inproj_store<0>(acc, V, row0, col0, rsv, ol, cd);
        else inproj_store<1>(acc, G, row0, col0, rsv, ol, cd);
    }
};
struct EpiRgIn {
    static constexpr bool PERM = true, PARTPF = true;
    bf16_t *XB, *GG; const float* part; float* conv_p; float* conv_s;
    __device__ __forceinline__ void operator()(const Acc& acc, const Unit& u, int wr, int wc, int fr, int fq, LAS unsigned char* lds) const {
        const int region = u.pn >> 2;
        const int row0 = u.pm * 256 + wr * 64 + fr, col0 = (u.pn & 3) * 256 + wc * 32 + 8 * fq;
        float rsv[8]; rows_rstd8_lds(lds + pg8::STAGE_BYTES, wr * 64 + fr, fr, fq, rsv);
        float ol[2][8]; float* cd[8];
#pragma unroll
        for (int r = 0; r < 8; ++r) { cd[r] = nullptr; ol[0][r] = 0.f; ol[1][r] = 0.f; }
        if (region == 0) {
            if (u.pm == 31 || u.pm == 63 || u.pm == 95 || u.pm >= 127) {
#pragma unroll
                for (int r = 0; r < 8; ++r) { const int row = row0 + (r >> 2) * 128 + (r & 3) * 16;
                    if (row < ROW_SAMPLE) { const int p = row & 8191; if (p >= 8189) cd[r] = conv_p + ((size_t)(row >> 13) * 3 + (p - 8189)) * D; }
                    else if (row < ROW_META) { const int p = row & 15; if (p >= 13) cd[r] = conv_s + ((size_t)((row - ROW_SAMPLE) >> 4) * 3 + (p - 13)) * D; } }
            }
            inproj_store<0>(acc, XB, row0, col0, rsv, ol, cd);
        } else inproj_store<3>(acc, GG, row0, col0, rsv, ol, cd);
    }
};
__device__ __forceinline__ float expm1_fast(float x) {
    const float p = x * (1.0f + x * (0.5f + x * (0.16666667f + x * (0.041666668f + x * (0.0083333338f + x * 0.0013888889f)))));
    return x > -0.25f ? p : __expf(x) - 1.0f;
}
struct EpiGate {
    static constexpr bool PERM = true, PARTPF = false; const float* part;
    const bf16_t* CF; bf16_t *OM, *UU; const float *ba, *bx, *sp;
    __device__ __forceinline__ void operator()(const Acc& acc, const Unit& u, int wr, int wc, int fr, int fq, LAS unsigned char* lds) const {
        const int row0 = u.pm * 256 + wr * 64 + fr, col0 = u.pn * 128 + wc * 32 + 8 * fq;
        constexpr float NL2E = -1.4426950409f;
#pragma unroll
        for (int n = 0; n < 2; ++n) {
            const f32x4 vba = *(const f32x4*)(ba + col0 + 4 * n) * NL2E, vbx = *(const f32x4*)(bx + col0 + 4 * n) * NL2E, vsp = *(const f32x4*)(sp + col0 + 4 * n) * (8.0f * NL2E);
            u32x2 cw[8];
#pragma unroll
            for (int r = 0; r < 8; ++r) cw[r] = *(const u32x2*)(CF + (size_t)(row0 + (r >> 2) * 128 + (r & 3) * 16) * D + col0 + 4 * n);
#pragma unroll
            for (int ai = 0; ai < 2; ++ai)
#pragma unroll
                for (int m = 0; m < 4; ++m) {
                    const size_t off = (size_t)(row0 + ai * 128 + m * 16) * D + col0 + 4 * n;
                    const u32x2 c2 = cw[ai * 4 + m]; unsigned wom[2], wuu[2];
#pragma unroll
                    for (int e2 = 0; e2 < 2; ++e2) {
                        const f32x2 ar = {acc[ai][0][m][n][2 * e2], acc[ai][0][m][n][2 * e2 + 1]}, ax = {acc[ai][1][m][n][2 * e2], acc[ai][1][m][n][2 * e2 + 1]};
                        const f32x2 br = {vba[2 * e2], vba[2 * e2 + 1]}, bxx = {vbx[2 * e2], vbx[2 * e2 + 1]}, sp2 = {vsp[2 * e2], vsp[2 * e2 + 1]};
                        const unsigned cwd = e2 ? c2.y : c2.x; const f32x2 cf = {bf_lo(cwd), bf_hi(cwd)};
                        f32x2 t = ar * NL2E + br; f32x2 d; d.x = __builtin_amdgcn_exp2f(t.x); d.y = __builtin_amdgcn_exp2f(t.y); d = d + 1.0f;
                        f32x2 r; r.x = __builtin_amdgcn_rcpf(d.x); r.y = __builtin_amdgcn_rcpf(d.y);
                        t = ax * NL2E + bxx; d.x = __builtin_amdgcn_exp2f(t.x); d.y = __builtin_amdgcn_exp2f(t.y); d = d + 1.0f;
                        f32x2 ig; ig.x = __builtin_amdgcn_rcpf(d.x); ig.y = __builtin_amdgcn_rcpf(d.y);
                        t = r * sp2; f32x2 ea; ea.x = __builtin_amdgcn_exp2f(t.x); ea.y = __builtin_amdgcn_exp2f(t.y);
                        const f32x2 om = 1.0f - ea;
                        t = om * (ea + 1.0f); f32x2 sq; sq.x = __builtin_amdgcn_sqrtf(t.x); sq.y = __builtin_amdgcn_sqrtf(t.y);
                        const f32x2 uu = (sq * ig) * cf;
                        wom[e2] = cvt_pk_bf16(om.x, om.y); wuu[e2] = cvt_pk_bf16(uu.x, uu.y); }
                    u32x2 w; w.x = wom[0]; w.y = wom[1]; gst8u(OM + off, w);
                    w.x = wuu[0]; w.y = wuu[1]; gst8u(UU + off, w);
                }
            asm volatile("" ::: "memory");
        }
    }
};

__device__ __forceinline__ void convert_tile(const float* src, int ldsrc, int K, const float* gvec, bf16_t* dst, int map, int t, int tid) {
    const int nk = K >> 7, tn = t / nk, tk = t - tn * nk, n0 = tn * 256, k0 = tk * 128 + (tid >> 6) * 16, lane = tid & 63;
    int c0 = n0 + 4 * lane; if (map) { const int pn = n0 >> 8; c0 = (lane < 32 ? 128 * pn + 4 * lane : DFF + 128 * pn + 4 * (lane - 32)); }
    const float* sp_ = src + (size_t)k0 * ldsrc + c0;
    f32x4 v[16];
#pragma unroll
    for (int j = 0; j < 16; ++j) v[j] = gld16f(sp_ + (size_t)j * ldsrc);
    if (gvec) {
#pragma unroll
        for (int j = 0; j < 16; ++j) v[j] *= gvec[k0 + j];
    }
    bf16_t* dp = dst + (size_t)(n0 + 4 * lane) * K + k0;
#pragma unroll
    for (int q = 0; q < 4; ++q) {
        u32x4 w0, w1;
        w0.x = cvt_pk_bf16(v[0][q], v[1][q]); w0.y = cvt_pk_bf16(v[2][q], v[3][q]); w0.z = cvt_pk_bf16(v[4][q], v[5][q]); w0.w = cvt_pk_bf16(v[6][q], v[7][q]);
        w1.x = cvt_pk_bf16(v[8][q], v[9][q]); w1.y = cvt_pk_bf16(v[10][q], v[11][q]); w1.z = cvt_pk_bf16(v[12][q], v[13][q]); w1.w = cvt_pk_bf16(v[14][q], v[15][q]);
        gst16(dp + (size_t)q * K, w0); gst16(dp + (size_t)q * K + 8, w1);
    }
}

__device__ __forceinline__ void phase_prep(LAS unsigned char* lds) { Params p; LOADP(ws); LOADP(out); LOADP(x_prompt); LOADP(x_sample); LOADP(meta); LOADP(a_lb); LOADP(b_lambda); LOADP(b_wa); LOADP(b_wx); LOADP(ffn_w_in); LOADP(ffn_norm); LOADP(ffn_w_out); LOADP(a_w_in); LOADP(mix_norm); LOADP(a_w_out); LOADP(b_w_in); LOADP(b_w_out);
    const int tid = otid(), G = gridDim.x, bid = obid(), lane = tid & 63, wave = tid >> 6;
    unsigned char* ws = p.ws;
    {
        float* hmain = p.out; float* htail = (float*)(ws + WS_HTAIL); bf16_t* hb = (bf16_t*)(ws + WS_HB); float* part = (float*)(ws + WS_PART);
        for (int rbase = bid * 8 + wave; rbase < MP; rbase += G * 8 * 4) {
            f32x4 x[4][4]; int rows[4];
#pragma unroll
            for (int k = 0; k < 4; ++k) { const int row = rbase + k * G * 8; rows[k] = row;
                const float* src = nullptr;
                if (row < ROW_SAMPLE) src = p.x_prompt + (size_t)row * D;
                else if (row < ROW_META) src = p.x_sample + (size_t)(row - ROW_SAMPLE) * D;
                else if (row < ROW_PAD) src = p.meta + (size_t)((row - ROW_META) & 15) * D;
#pragma unroll
                for (int i = 0; i < 4; ++i) x[k][i] = src ? gld16f(src + i * 256 + lane * 4) : (f32x4){0.f, 0.f, 0.f, 0.f}; }
#pragma unroll
            for (int k = 0; k < 4; ++k) { const int row = rows[k]; if (row >= MP) continue;
                float ss = 0.f;
#pragma unroll
                for (int i = 0; i < 4; ++i) { const int c = i * 256 + lane * 4; const f32x4 v = x[k][i];
                    ss += (v[0] * v[0] + v[1] * v[1]) + (v[2] * v[2] + v[3] * v[3]);
                    u32x2 w; w.x = cvt_pk_bf16(v[0], v[1]); w.y = cvt_pk_bf16(v[2], v[3]); gst8u(hb + (size_t)row * D + c, w); }
#pragma unroll
                for (int o = 32; o >= 1; o >>= 1) ss += shx(ss, o, lane);
                if (lane < 16) part[(size_t)row * 16 + lane] = lane == 0 ? ss : 0.f;
            }
        }
    }
    {
        float* oml = (float*)(ws + WS_VEC); float* sp = oml + 1024;
        for (int i = bid * NTHR + tid; i < 1024; i += G * NTHR) {
            oml[i] = 1.0f / (1.0f + expf(p.a_lb[i] - p.a_lb[1024 + i]));
            const float l = -p.b_lambda[i]; sp[i] = l > 20.f ? l : log1pf(expf(l));
        }
        bf16_t* wg = (bf16_t*)(ws + W_G);
        for (int i = bid * NTHR + tid; i < 8 * 256 * 128; i += G * NTHR) {
            const int pn = i >> 15, nrow = (i >> 7) & 255, kk = i & 127;
            const float* w = nrow < 128 ? p.b_wa : p.b_wx; const float v = w[((size_t)pn * 128 + kk) * 128 + (nrow & 127)];
            wg[i] = (bf16_t)(cvt_pk_bf16(v, 0.f) & 0xffffu);
        }
    }
    for (int w = bid; w < 1312; w += G) {
        int t = w;
        if (t < 704) { const int i = t / 176; t -= i * 176; convert_tile(p.ffn_w_in + (size_t)i * D * 2 * DFF, 2 * DFF, D, p.ffn_norm + (size_t)i * D, (bf16_t*)(ws + W_FFN_IN + i * SZ_FFN_IN), 1, t, tid); continue; }
        t -= 704;
        if (t < 352) { const int i = t / 88; t -= i * 88; convert_tile(p.ffn_w_out + (size_t)i * DFF * D, D, DFF, nullptr, (bf16_t*)(ws + W_FFN_OUT + i * SZ_FFN_OUT), 0, t, tid); continue; }
        t -= 352;
        if (t < 128) { convert_tile(p.a_w_in, 4096, D, p.mix_norm, (bf16_t*)(ws + W_A_IN), 0, t, tid); continue; }
        t -= 128;
        if (t < 32) { convert_tile(p.a_w_out, D, D, nullptr, (bf16_t*)(ws + W_A_OUT), 0, t, tid); continue; }
        t -= 32;
        if (t < 64) { convert_tile(p.b_w_in, 2048, D, p.mix_norm + D, (bf16_t*)(ws + W_B_IN), 0, t, tid); continue; }
        t -= 64;
        convert_tile(p.b_w_out, D, D, nullptr, (bf16_t*)(ws + W_B_OUT), 0, t, tid);
    }
}

typedef short bf16x4 __attribute__((ext_vector_type(4)));
template <int CTRL> __device__ __forceinline__ float dpp_f(float x) { return __int_as_float(__builtin_amdgcn_update_dpp(0, __float_as_int(x), CTRL, 0xf, 0xf, true)); }
__device__ __forceinline__ float bperm(int srclane, float v) { return __int_as_float(__builtin_amdgcn_ds_bpermute(srclane << 2, __float_as_int(v))); }
constexpr int GL_QD = 0, GL_KD = 4352, GL_KKT = 8704, GL_VT = 13824, GL_DEC = 18944, GL_RED = 19456, GL_BUF = 19712, GL_GRP = 2 * GL_BUF;

#define GAS __attribute__((address_space(1)))
__device__ __forceinline__ u32x4 gld16(const bf16_t* p) { return *(const GAS u32x4*)(const GAS void*)p; }
__device__ __forceinline__ u32x2 gld8(const bf16_t* p) { return *(const GAS u32x2*)(const GAS void*)p; }
__device__ __forceinline__ void gst8(bf16_t* p, u32x2 v) { *(GAS u32x2*)(GAS void*)p = v; }
template <bool OUT>
__device__ __forceinline__ void gla_mfma(LAS unsigned char* lds, const bf16_t* Qb, const bf16_t* Kb, const bf16_t* Vb, const bf16_t* Gb, bf16_t* Yb, int row0, int nblk, int h,
                                         const float* Sin, float* Sout, float* Dout, const float* onorm, int tid, bool tin, bool tout) {
    const int g = tid >> 8, gt = tid & 255, w = gt >> 6, lane = tid & 63, fr = lane & 15, quad = lane >> 4, g8 = gt >> 4;
    LAS unsigned char* L0 = lds + g * GL_GRP;
    f32x4 S[8][2];
    {
        if (tin) {
            int tb = (w * 64 + lane) * 4; asm volatile("" : "+v"(tb)); const GAS f32x4* sp4 = (const GAS f32x4*)(const GAS void*)(Sin + tb);
#pragma unroll
            for (int m = 0; m < 8; ++m)
#pragma unroll
                for (int n = 0; n < 2; ++n) S[m][n] = sp4[(m * 2 + n) * 256];
        } else {
        int sb = (4 * quad) * 128 + 32 * w + fr; asm volatile("" : "+v"(sb)); const GAS float* sp_ = (const GAS float*)(const GAS void*)(Sin + sb);
#pragma unroll
        for (int m = 0; m < 8; ++m)
#pragma unroll
            for (int n = 0; n < 2; ++n)
#pragma unroll
                for (int i = 0; i < 4; ++i) S[m][n][i] = sp_[(16 * m + i) * 128 + 16 * n];
        }
    }
    float bsum[8];
#pragma unroll
    for (int j = 0; j < 8; ++j) bsum[j] = 0.f;
    const size_t coff = (size_t)h * 128 + 8 * g8;
    u32x4 kw = gld16(Kb + (size_t)(row0 + fr) * D + coff), vw = gld16(Vb + (size_t)(row0 + fr) * D + coff), qw = kw;
    if (OUT) qw = gld16(Qb + (size_t)(row0 + fr) * D + coff);
    auto stage_a = [&](LAS unsigned char* L, const u32x4 kwv, const u32x4 qwv, const u32x4 vwv) {
        const unsigned kk_[4] = {kwv.x, kwv.y, kwv.z, kwv.w}, qq_[4] = {qwv.x, qwv.y, qwv.z, qwv.w}, vv_[4] = {vwv.x, vwv.y, vwv.z, vwv.w};
        float kf[8], bb[8], bl[8];
#pragma unroll
        for (int j = 0; j < 8; ++j) { kf[j] = (j & 1) ? bf_hi(kk_[j >> 1]) : bf_lo(kk_[j >> 1]);
            float x = __builtin_amdgcn_logf(1.0f - kf[j]);
            x += dpp_f<0x111>(x); x += dpp_f<0x112>(x); x += dpp_f<0x114>(x); x += dpp_f<0x118>(x);
            bb[j] = x; }
#pragma unroll
        for (int j = 0; j < 8; ++j) bl[j] = bperm(lane | 15, bb[j]);
        float qd[8], kd[8], kx[8];
#pragma unroll
        for (int jp = 0; jp < 4; ++jp) {
            const f32x2 k2 = {kf[2 * jp], kf[2 * jp + 1]}, b2 = {bb[2 * jp], bb[2 * jp + 1]}, l2 = {bl[2 * jp], bl[2 * jp + 1]};
            const f32x2 df = l2 - b2; f32x2 e; e.x = __builtin_amdgcn_exp2f(df.x); e.y = __builtin_amdgcn_exp2f(df.y);
            const f32x2 kx2 = k2 * e; kx[2 * jp] = kx2.x; kx[2 * jp + 1] = kx2.y;
            if (OUT) { const f32x2 q2 = {bf_lo(qq_[jp]), bf_hi(qq_[jp])};
                f32x2 e1; e1.x = __builtin_amdgcn_exp2f(b2.x); e1.y = __builtin_amdgcn_exp2f(b2.y);
                f32x2 e2; e2.x = __builtin_amdgcn_exp2f(-b2.x); e2.y = __builtin_amdgcn_exp2f(-b2.y);
                const f32x2 qd2 = q2 * e1, kd2 = k2 * e2; qd[2 * jp] = qd2.x; qd[2 * jp + 1] = qd2.y; kd[2 * jp] = kd2.x; kd[2 * jp + 1] = kd2.y; } }
        if (OUT) {
            u32x4 wq, wk; wq.x = cvt_pk_bf16(qd[0], qd[1]); wq.y = cvt_pk_bf16(qd[2], qd[3]); wq.z = cvt_pk_bf16(qd[4], qd[5]); wq.w = cvt_pk_bf16(qd[6], qd[7]);
            wk.x = cvt_pk_bf16(kd[0], kd[1]); wk.y = cvt_pk_bf16(kd[2], kd[3]); wk.z = cvt_pk_bf16(kd[4], kd[5]); wk.w = cvt_pk_bf16(kd[6], kd[7]);
            *(LAS u32x4*)(L + GL_QD + fr * 272 + g8 * 16) = wq; *(LAS u32x4*)(L + GL_KD + fr * 272 + g8 * 16) = wk;
        }
#pragma unroll
        for (int j = 0; j < 8; j += 2) { const unsigned pk = cvt_pk_bf16(kx[j], kx[j + 1]);
            *(LAS unsigned short*)(L + GL_KKT + (8 * g8 + j) * 40 + fr * 2) = (unsigned short)(pk & 0xffffu);
            *(LAS unsigned short*)(L + GL_KKT + (8 * g8 + j + 1) * 40 + fr * 2) = (unsigned short)(pk >> 16);
            *(LAS unsigned short*)(L + GL_VT + (8 * g8 + j) * 40 + fr * 2) = (unsigned short)(vv_[j >> 1] & 0xffffu);
            *(LAS unsigned short*)(L + GL_VT + (8 * g8 + j + 1) * 40 + fr * 2) = (unsigned short)(vv_[j >> 1] >> 16); }
        if (fr == 0) { *(LAS f32x4*)(L + GL_DEC + g8 * 32) = (f32x4){__builtin_amdgcn_exp2f(bl[0]), __builtin_amdgcn_exp2f(bl[1]), __builtin_amdgcn_exp2f(bl[2]), __builtin_amdgcn_exp2f(bl[3])};
                       *(LAS f32x4*)(L + GL_DEC + g8 * 32 + 16) = (f32x4){__builtin_amdgcn_exp2f(bl[4]), __builtin_amdgcn_exp2f(bl[5]), __builtin_amdgcn_exp2f(bl[6]), __builtin_amdgcn_exp2f(bl[7])}; }
        if (!OUT) {
#pragma unroll
            for (int j = 0; j < 8; ++j) bsum[j] += bl[j];
        }
    };
    stage_a(L0, kw, qw, vw);
    if (nblk > 1) { const size_t o = (size_t)(row0 + 16 + fr) * D + coff; kw = gld16(Kb + o); vw = gld16(Vb + o); if (OUT) qw = gld16(Qb + o); }
    __syncthreads();
    f32x4 n0 = (f32x4){0.f, 0.f, 0.f, 0.f}, n1 = n0;
    if (OUT) { n0 = *(const f32x4*)(onorm + h * 128 + 32 * w + 4 * quad); n1 = *(const f32x4*)(onorm + h * 128 + 32 * w + 16 + 4 * quad); }
    for (int blk = 0; blk < nblk; ++blk) {
        const int rb = row0 + blk * 16;
        LAS unsigned char* L = L0 + (blk & 1) * GL_BUF;
        bf16x4 vfr[2];
#pragma unroll
        for (int n = 0; n < 2; ++n) vfr[n] = *(const LAS bf16x4*)(L + GL_VT + (32 * w + 16 * n + fr) * 40 + quad * 8);
        f32x4 o[2];
        if (OUT) {
            bf16x8 qf[4];
            f32x4 sc = (f32x4){0.f, 0.f, 0.f, 0.f};
#pragma unroll
            for (int kb = 0; kb < 4; ++kb) {
                const bf16x4 q0 = *(const LAS bf16x4*)(L + GL_QD + fr * 272 + (32 * kb + 4 * quad) * 2), q1 = *(const LAS bf16x4*)(L + GL_QD + fr * 272 + (32 * kb + 16 + 4 * quad) * 2);
                const bf16x4 k0 = *(const LAS bf16x4*)(L + GL_KD + fr * 272 + (32 * kb + 4 * quad) * 2), k1 = *(const LAS bf16x4*)(L + GL_KD + fr * 272 + (32 * kb + 16 + 4 * quad) * 2);
                qf[kb] = (bf16x8){q0[0], q0[1], q0[2], q0[3], q1[0], q1[1], q1[2], q1[3]};
                const bf16x8 kfv = (bf16x8){k0[0], k0[1], k0[2], k0[3], k1[0], k1[1], k1[2], k1[3]};
                sc = __builtin_amdgcn_mfma_f32_16x16x32_bf16(kfv, qf[kb], sc, 0, 0, 0);
            }
#pragma unroll
            for (int i = 0; i < 4; ++i) sc[i] = (4 * quad + i <= fr) ? sc[i] : 0.f;
            bf16x4 P; { const unsigned p0 = cvt_pk_bf16(sc[0], sc[1]), p1 = cvt_pk_bf16(sc[2], sc[3]); P = (bf16x4){(short)(p0 & 0xffffu), (short)(p0 >> 16), (short)(p1 & 0xffffu), (short)(p1 >> 16)}; }
#pragma unroll
            for (int n = 0; n < 2; ++n) {
                o[n] = (f32x4){0.f, 0.f, 0.f, 0.f};
#pragma unroll
                for (int kb = 0; kb < 4; ++kb) {
                    const unsigned a0 = cvt_pk_bf16(S[2 * kb][n][0], S[2 * kb][n][1]), a1 = cvt_pk_bf16(S[2 * kb][n][2], S[2 * kb][n][3]);
                    const unsigned a2 = cvt_pk_bf16(S[2 * kb + 1][n][0], S[2 * kb + 1][n][1]), a3 = cvt_pk_bf16(S[2 * kb + 1][n][2], S[2 * kb + 1][n][3]);
                    const bf16x8 sa = (bf16x8){(short)(a0 & 0xffffu), (short)(a0 >> 16), (short)(a1 & 0xffffu), (short)(a1 >> 16), (short)(a2 & 0xffffu), (short)(a2 >> 16), (short)(a3 & 0xffffu), (short)(a3 >> 16)};
                    o[n] = __builtin_amdgcn_mfma_f32_16x16x32_bf16(sa, qf[kb], o[n], 0, 0, 0);
                }
                asm volatile("s_nop 7\n\ts_nop 3" : "+v"(o[n]));
                o[n] = __builtin_amdgcn_mfma_f32_16x16x16bf16_1k(vfr[n], P, o[n], 0, 0, 0);
            }
            asm volatile("s_nop 7\n\ts_nop 7" : "+v"(o[0]), "+v"(o[1]));
        }
#pragma unroll
        for (int m = 0; m < 8; ++m) {
            const bf16x4 kkf = *(const LAS bf16x4*)(L + GL_KKT + (16 * m + fr) * 40 + quad * 8);
            const f32x4 dec = *(const LAS f32x4*)(L + GL_DEC + (16 * m + 4 * quad) * 4);
#pragma unroll
            for (int n = 0; n < 2; ++n) S[m][n] = __builtin_amdgcn_mfma_f32_16x16x16bf16_1k(kkf, vfr[n], S[m][n] * dec, 0, 0, 0);
        }
        if (blk + 1 < nblk) {
            stage_a(L0 + ((blk + 1) & 1) * GL_BUF, kw, qw, vw);
            if (blk + 2 < nblk) { const size_t o2 = (size_t)(rb + 32 + fr) * D + coff; kw = gld16(Kb + o2); vw = gld16(Vb + o2); if (OUT) qw = gld16(Qb + o2); }
        }
        if (!OUT) __syncthreads();
        if (OUT) {
            float ss = 0.f;
#pragma unroll
            for (int n = 0; n < 2; ++n) ss += (o[n][0] * o[n][0] + o[n][1] * o[n][1]) + (o[n][2] * o[n][2] + o[n][3] * o[n][3]);
            ss += shx(ss, 16, lane); ss += shx(ss, 32, lane);
            if (quad == 0) *(LAS float*)(L + GL_RED + (w * 16 + fr) * 4) = ss;
            const size_t yoff = (size_t)(rb + fr) * D + h * 128 + 32 * w + 4 * quad;
            const u32x2 g0 = gld8(Gb + yoff), g1 = gld8(Gb + yoff + 16);
            __syncthreads();
            const float tot = (*(const LAS float*)(L + GL_RED + fr * 4) + *(const LAS float*)(L + GL_RED + (16 + fr) * 4)) + (*(const LAS float*)(L + GL_RED + (32 + fr) * 4) + *(const LAS float*)(L + GL_RED + (48 + fr) * 4));
            const float rs = rsqrtf(tot * (1.0f / 128.0f) + EPS);
            u32x2 y0, y1;
            { const f32x2 a = {o[0][0], o[0][1]}, b = {o[0][2], o[0][3]}, c = {o[1][0], o[1][1]}, d = {o[1][2], o[1][3]};
              const f32x2 na = {n0[0], n0[1]}, nb = {n0[2], n0[3]}, nc = {n1[0], n1[1]}, nd = {n1[2], n1[3]};
              const f32x2 ga = {bf_lo(g0.x), bf_hi(g0.x)}, gb = {bf_lo(g0.y), bf_hi(g0.y)}, gc = {bf_lo(g1.x), bf_hi(g1.x)}, gd = {bf_lo(g1.y), bf_hi(g1.y)};
              const f32x2 ya = (a * rs) * (na * ga), yb = (b * rs) * (nb * gb), yc = (c * rs) * (nc * gc), yd = (d * rs) * (nd * gd);
              y0.x = cvt_pk_bf16(ya.x, ya.y); y0.y = cvt_pk_bf16(yb.x, yb.y); y1.x = cvt_pk_bf16(yc.x, yc.y); y1.y = cvt_pk_bf16(yd.x, yd.y); }
            gst8(Yb + yoff, y0); gst8(Yb + yoff + 16, y1);
        }
    }
    asm volatile("s_nop 7\n\ts_nop 7" : "+v"(S[7][0]), "+v"(S[7][1]), "+v"(S[6][0]), "+v"(S[6][1]));
    if (Sout && tout) {
        int tb = (w * 64 + lane) * 4; asm volatile("" : "+v"(tb)); GAS f32x4* sp4 = (GAS f32x4*)(GAS void*)(Sout + tb);
#pragma unroll
        for (int m = 0; m < 8; ++m)
#pragma unroll
            for (int n = 0; n < 2; ++n) sp4[(m * 2 + n) * 256] = S[m][n];
    }
    if (Sout && !tout) {
        int sb = (4 * quad) * 128 + 32 * w + fr; asm volatile("" : "+v"(sb)); float* sp_ = Sout + sb;
#pragma unroll
        for (int m = 0; m < 8; ++m)
#pragma unroll
            for (int n = 0; n < 2; ++n)
#pragma unroll
                for (int i = 0; i < 4; ++i) sp_[(16 * m + i) * 128 + 16 * n] = S[m][n][i];
    }
    if (!OUT && Dout && fr == 0) {
#pragma unroll
        for (int j = 0; j < 8; ++j) Dout[8 * g8 + j] = __builtin_amdgcn_exp2f(bsum[j]);
    }
}

__device__ __forceinline__ void gla_chunk_rows(int seq, int c, int& row0, int& nblk) { if (c == 0) { row0 = ROW_META + 16 * seq; nblk = 1; } else { row0 = 8192 * seq + 256 * (c - 1); nblk = 16; } }

__device__ __forceinline__ void phase_gla1(LAS unsigned char* lds) { Params p; LOADP(ws);
    unsigned char* ws = p.ws; float* SST = (float*)(ws + SC_SST); float* DC = (float*)(ws + SC_DC);
    const int tid = otid();
    for (int pi = obid(); pi < 512; pi += gridDim.x) {
        const int i = 2 * pi + (tid >> 8); int seq, h, c;
        if (i < 992) { seq = i / 248; const int r = i - seq * 248; h = r / 31; c = 1 + (r - h * 31); } else { seq = (i - 992) >> 3; h = (i - 992) & 7; c = 0; }
        int row0, nblk; gla_chunk_rows(seq, c, row0, nblk);
        const size_t sh = (size_t)(seq * 8 + h) * NCH;
        gla_mfma<false>(lds, nullptr, (const bf16_t*)(ws + SC_K), (const bf16_t*)(ws + SC_V), nullptr, nullptr, row0, nblk, h, (const float*)(ws + WS_ZERO), SST + (sh + c + 1) * 16384, DC + (sh + c) * 128, nullptr, tid, true, true);
        __syncthreads();
    }
}
__device__ __forceinline__ void phase_gla2() { Params p; LOADP(ws);
    unsigned char* ws = p.ws; float* SST = (float*)(ws + SC_SST); const float* DC = (const float*)(ws + SC_DC);
    for (int idx = obid() * NTHR + otid(); idx < 32 * 4096; idx += gridDim.x * NTHR) {
        const int sh = idx >> 12, e4 = idx & 4095, m = e4 >> 9, quad = (e4 >> 4) & 3, dk0 = 16 * m + 4 * quad;
        float* base = SST + (size_t)sh * NCH * 16384 + e4 * 4; const float* dcb = DC + (size_t)sh * NCH * 128 + dk0;
        f32x4 v[32];
#pragma unroll
        for (int c = 0; c < 32; ++c) v[c] = *(const f32x4*)(base + (size_t)(c + 1) * 16384);
#pragma unroll
        for (int cb = 0; cb < 4; ++cb) {
            f32x4 dv[8];
#pragma unroll
            for (int j = 0; j < 8; ++j) dv[j] = *(const f32x4*)(dcb + (size_t)(cb * 8 + j) * 128);
#pragma unroll
            for (int j = 0; j < 8; ++j) { const int c = cb * 8 + j; if (c >= 1) { v[c] += v[c - 1] * dv[j]; *(f32x4*)(base + (size_t)(c + 1) * 16384) = v[c]; } }
        }
    }
}
__device__ __forceinline__ void phase_gla3(LAS unsigned char* lds) { Params p; LOADP(ws); LOADP(out); LOADP(state_hgrn); LOADP(a_onorm);
    unsigned char* ws = p.ws; float* SST = (float*)(ws + SC_SST);
    const bf16_t *Qb = (const bf16_t*)(ws + SC_Q), *Kb = (const bf16_t*)(ws + SC_K), *Vb = (const bf16_t*)(ws + SC_V), *Gb = (const bf16_t*)(ws + SC_G); bf16_t* Yb = (bf16_t*)(ws + SC_G);
    const int tid = otid();
    for (int pi = obid(); pi < 592; pi += gridDim.x) {
        const int i = 2 * pi + (tid >> 8);
        int row0, nblk, h; const float* Sin = (const float*)(ws + WS_ZERO); float* Sout = nullptr;
        if (i < 1056) {
            int seq, c; if (i < 1024) { seq = i >> 8; h = (i >> 5) & 7; c = 1 + (i & 31); } else { seq = (i - 1024) >> 3; h = (i - 1024) & 7; c = 0; }
            gla_chunk_rows(seq, c, row0, nblk);
            if (c > 0) Sin = SST + ((size_t)(seq * 8 + h) * NCH + c) * 16384;
            if (c == 32) Sout = p.out + O_HP + (size_t)(seq * 8 + h) * 16384;
        } else {
            const int j = i - 1056, sidx = j >> 3; h = j & 7; row0 = ROW_SAMPLE + 16 * sidx; nblk = 1;
            Sin = p.state_hgrn + (size_t)(sidx * 8 + h) * 16384; Sout = p.out + O_HS + (size_t)(sidx * 8 + h) * 16384;
        }
        gla_mfma<true>(lds, Qb, Kb, Vb, Gb, Yb, row0, nblk, h, Sin, Sout, nullptr, p.a_onorm, tid, pi < 512, false);
        __syncthreads();
    }
}

__device__ __forceinline__ void unpack8(const u32x4 w, float (&x)[8]) { x[0] = bf_lo(w.x); x[1] = bf_hi(w.x); x[2] = bf_lo(w.y); x[3] = bf_hi(w.y); x[4] = bf_lo(w.z); x[5] = bf_hi(w.z); x[6] = bf_lo(w.w); x[7] = bf_hi(w.w); }
__device__ __forceinline__ void phase_conv() { Params p; LOADP(ws); LOADP(b_conv_b); LOADP(b_conv_w); LOADP(state_conv);
    unsigned char* ws = p.ws; const bf16_t* XB = (const bf16_t*)(ws + SC_XB); bf16_t* CF = (bf16_t*)(ws + SC_CF);
    const int tid = otid(), lane = tid & 63, wave = tid >> 6;
    for (int g = obid() * 8 + wave; g < MP / 16; g += gridDim.x * 8) {
        const int r0 = g * 16;
#pragma unroll
        for (int half = 0; half < 2; ++half) {
            const int c = half * 512 + lane * 8;
            if (r0 >= ROW_PAD) {
#pragma unroll
                for (int t = 0; t < 16; ++t) gst16(CF + (size_t)(r0 + t) * D + c, (u32x4){0u, 0u, 0u, 0u});
                continue;
            }
            u32x4 xw[16];
#pragma unroll
            for (int t = 0; t < 16; ++t) xw[t] = gld16(XB + (size_t)(r0 + t) * D + c);
            float hx[3][8];
            if (r0 < ROW_SAMPLE) {
                const int hb0 = (r0 & 8191) == 0 ? ROW_META + 16 * (r0 >> 13) + 13 : r0 - 3;
#pragma unroll
                for (int j = 0; j < 3; ++j) unpack8(gld16(XB + (size_t)(hb0 + j) * D + c), hx[j]);
            } else if (r0 < ROW_META) {
                const float* sc_ = p.state_conv + (size_t)((r0 - ROW_SAMPLE) >> 4) * 3 * D + c;
#pragma unroll
                for (int j = 0; j < 3; ++j) { const f32x4 a = *(const f32x4*)(sc_ + (size_t)j * D), b2 = *(const f32x4*)(sc_ + (size_t)j * D + 4);
#pragma unroll
                    for (int e = 0; e < 4; ++e) { hx[j][e] = a[e]; hx[j][4 + e] = b2[e]; } }
            } else {
#pragma unroll
                for (int j = 0; j < 3; ++j)
#pragma unroll
                    for (int e = 0; e < 8; ++e) hx[j][e] = 0.f;
            }
            float wv[4][8], bv[8];
#pragma unroll
            for (int j = 0; j < 4; ++j) { const f32x4 a = *(const f32x4*)(p.b_conv_w + (size_t)j * D + c), b2 = *(const f32x4*)(p.b_conv_w + (size_t)j * D + c + 4);
#pragma unroll
                for (int e = 0; e < 4; ++e) { wv[j][e] = a[e]; wv[j][4 + e] = b2[e]; } }
            { const f32x4 a = *(const f32x4*)(p.b_conv_b + c), b2 = *(const f32x4*)(p.b_conv_b + c + 4);
#pragma unroll
              for (int e = 0; e < 4; ++e) { bv[e] = a[e]; bv[4 + e] = b2[e]; } }
#pragma unroll
            for (int t = 0; t < 16; ++t) {
                float x[8], o[8]; unpack8(xw[t], x);
#pragma unroll
                for (int e = 0; e < 8; ++e) { o[e] = fmaf(x[e], wv[3][e], fmaf(hx[2][e], wv[2][e], fmaf(hx[1][e], wv[1][e], fmaf(hx[0][e], wv[0][e], bv[e]))));
                    hx[0][e] = hx[1][e]; hx[1][e] = hx[2][e]; hx[2][e] = x[e]; }
                u32x4 w; w.x = cvt_pk_bf16(o[0], o[1]); w.y = cvt_pk_bf16(o[2], o[3]); w.z = cvt_pk_bf16(o[4], o[5]); w.w = cvt_pk_bf16(o[6], o[7]);
                gst16(CF + (size_t)(r0 + t) * D + c, w);
            }
        }
    }
}
__device__ __forceinline__ void rg_chunk_rows(int seq, int c, int& row0, int& ntok) { if (c == 0) { row0 = ROW_META + 16 * seq; ntok = 16; } else { row0 = 8192 * seq + 64 * (c - 1); ntok = 64; } }
__device__ __forceinline__ void phase_scan1() { Params p; LOADP(ws);
    unsigned char* ws = p.ws; const bf16_t* OM = (const bf16_t*)(ws + SC_OM); const bf16_t* UU = (const bf16_t*)(ws + SC_UU); f32x4* AB = (f32x4*)(ws + SC_AB);
    const int tid = otid(), sub = tid >> 8, tt = tid & 255;
    for (int i = 2 * obid() + sub; i < 4 * (RCH - 1); i += 2 * gridDim.x) {
        const int seq = i / (RCH - 1), c = i % (RCH - 1);
        int row0, ntok; rg_chunk_rows(seq, c, row0, ntok);
        float a[4] = {1.f, 1.f, 1.f, 1.f}, h[4] = {0.f, 0.f, 0.f, 0.f};
#pragma unroll 16
        for (int t = 0; t < ntok; ++t) { const size_t o = (size_t)(row0 + t) * D + 4 * tt; const u32x2 om = gld8(OM + o), uu = gld8(UU + o);
            const float x0 = 1.0f - bf_lo(om.x), x1 = 1.0f - bf_hi(om.x), x2 = 1.0f - bf_lo(om.y), x3 = 1.0f - bf_hi(om.y);
            h[0] = fmaf(x0, h[0], bf_lo(uu.x)); h[1] = fmaf(x1, h[1], bf_hi(uu.x)); h[2] = fmaf(x2, h[2], bf_lo(uu.y)); h[3] = fmaf(x3, h[3], bf_hi(uu.y));
            a[0] *= x0; a[1] *= x1; a[2] *= x2; a[3] *= x3; }
        f32x4* ab = AB + (size_t)(seq * RCH + c) * 512 + 2 * tt;
        ab[0] = (f32x4){a[0], h[0], a[1], h[1]}; ab[1] = (f32x4){a[2], h[2], a[3], h[3]};
    }
}
__device__ __forceinline__ void phase_scan3() { Params p; LOADP(ws); LOADP(out); LOADP(state_rglru);
    unsigned char* ws = p.ws; const bf16_t* OM = (const bf16_t*)(ws + SC_OM); const bf16_t* UU = (const bf16_t*)(ws + SC_UU); const f32x4* AB = (const f32x4*)(ws + SC_AB);
    bf16_t* GY = (bf16_t*)(ws + SC_GG);
    const int tid = otid(), sub = tid >> 8, tt = tid & 255;
    for (int i = 2 * obid() + sub; i < 4 * RCH + 16; i += 2 * gridDim.x) {
        int row0, ntok; float h[4] = {0.f, 0.f, 0.f, 0.f}; float* hout = nullptr;
        if (i < 4 * RCH) {
            int seq, c; if (i < 512) { seq = i & 3; c = 128 - (i >> 2); } else { seq = i - 512; c = 0; }
            rg_chunk_rows(seq, c, row0, ntok);
#pragma unroll 16
            for (int j = 0; j < c; ++j) { const f32x4* ab = AB + (size_t)(seq * RCH + j) * 512 + 2 * tt; const f32x4 p0 = ab[0], p1 = ab[1];
                h[0] = fmaf(p0[0], h[0], p0[1]); h[1] = fmaf(p0[2], h[1], p0[3]); h[2] = fmaf(p1[0], h[2], p1[1]); h[3] = fmaf(p1[2], h[3], p1[3]); }
            if (c == RCH - 1) hout = p.out + O_RP + (size_t)seq * D;
        } else {
            const int s_ = i - 4 * RCH; row0 = ROW_SAMPLE + 16 * s_; ntok = 16;
            const f32x4 hh = *(const f32x4*)(p.state_rglru + (size_t)s_ * D + 4 * tt); h[0] = hh[0]; h[1] = hh[1]; h[2] = hh[2]; h[3] = hh[3]; hout = p.out + O_RS + (size_t)s_ * D;
        }
        for (int t0 = 0; t0 < ntok; t0 += 16) {
            u32x2 om[16], uu[16], gg[16];
#pragma unroll
            for (int t = 0; t < 16; ++t) { const size_t o = (size_t)(row0 + t0 + t) * D + 4 * tt; om[t] = gld8(OM + o); uu[t] = gld8(UU + o); gg[t] = gld8(GY + o); }
#pragma unroll
            for (int t = 0; t < 16; ++t) {
                h[0] = fmaf(1.0f - bf_lo(om[t].x), h[0], bf_lo(uu[t].x)); h[1] = fmaf(1.0f - bf_hi(om[t].x), h[1], bf_hi(uu[t].x));
                h[2] = fmaf(1.0f - bf_lo(om[t].y), h[2], bf_lo(uu[t].y)); h[3] = fmaf(1.0f - bf_hi(om[t].y), h[3], bf_hi(uu[t].y));
                u32x2 y; y.x = cvt_pk_bf16(h[0] * bf_lo(gg[t].x), h[1] * bf_hi(gg[t].x)); y.y = cvt_pk_bf16(h[2] * bf_lo(gg[t].y), h[3] * bf_hi(gg[t].y));
                gst8(GY + (size_t)(row0 + t0 + t) * D + 4 * tt, y); }
        }
        if (hout) *(f32x4*)(hout + 4 * tt) = (f32x4){h[0], h[1], h[2], h[3]};
    }
}
__device__ __forceinline__ void phase_final(const float* part) { Params p; LOADP(out); LOADP(final_norm);
    const int tid = otid(), lane = tid & 63, wave = tid >> 6;
    f32x4 gn[4];
#pragma unroll
    for (int i = 0; i < 4; ++i) gn[i] = *(const f32x4*)(p.final_norm + i * 256 + lane * 4);
    const int G8 = gridDim.x * 8;
    for (int rbase = obid() * 8 + wave; rbase < ROW_META; rbase += G8 * 4) {
        f32x4 x[4][4]; float sv[4];
#pragma unroll
        for (int k = 0; k < 4; ++k) { const int row = rbase + k * G8; const bool ok = row < ROW_META; const int rr = ok ? row : 0;
            sv[k] = lane < 16 ? part[(size_t)rr * 16 + lane] : 0.f;
#pragma unroll
            for (int i = 0; i < 4; ++i) x[k][i] = gld16f(p.out + (size_t)rr * D + i * 256 + lane * 4); }
#pragma unroll
        for (int k = 0; k < 4; ++k) { const int row = rbase + k * G8; if (row >= ROW_META) continue;
            float s_ = sv[k];
#pragma unroll
            for (int o = 8; o >= 1; o >>= 1) s_ += shx(s_, o, lane);
            s_ = __int_as_float(__builtin_amdgcn_readfirstlane(__float_as_int(s_)));
            const float rs = rsqrtf(s_ * (1.0f / 1024.0f) + EPS); float* hp = p.out + (size_t)row * D;
#pragma unroll
            for (int i = 0; i < 4; ++i) gst16f(hp + i * 256 + lane * 4, x[k][i] * rs * gn[i]); }
    }
}


#define XB_TMO      128
#define XB_XCNT(j)  (256  + 64 * (j))
#define XB_XSUB(j)  (1280 + 64 * (j))
#define XB_XGEN(j)  (2304 + 64 * (j))
#define XB_TOP      3328
#define XB_TOPGEN   3392
#define XCD_BAR_WORDS 3456
#define XB_SPIN_CAP (1u << 18)
__device__ __forceinline__ unsigned xb_ld(unsigned* p)              { return __hip_atomic_load(p, __ATOMIC_RELAXED, __HIP_MEMORY_SCOPE_AGENT); }
__device__ __forceinline__ unsigned xb_add(unsigned* p, unsigned v) { return __hip_atomic_fetch_add(p, v, __ATOMIC_RELAXED, __HIP_MEMORY_SCOPE_AGENT); }
__device__ __forceinline__ unsigned xb_xcc_id() { return (unsigned)__builtin_amdgcn_s_getreg((3 << 11) | 20) & 0xFu; }
#define XB_SPIN(cond, bar) do { unsigned _sp = 0; while (cond) { __builtin_amdgcn_s_sleep(1); \
    if ((++_sp & 255u) == 0u) { if (xb_ld(&(bar)[XB_TMO])) break; if (_sp > XB_SPIN_CAP) { atomicAdd(&(bar)[XB_TMO], 1u); break; } } } } while (0)
struct XcdBarrier { unsigned* bar; unsigned x; volatile LAS unsigned* st; };
__device__ __forceinline__ XcdBarrier xcd_barrier_post(unsigned* bar, volatile LAS unsigned* st) {
    XcdBarrier b; b.bar = bar; b.x = xb_xcc_id(); b.st = st;
    if (threadIdx.x == 0) (void)xb_add(&bar[XB_XCNT(b.x)], 1u);
    return b;
}
__device__ __forceinline__ void xcd_barrier_complete(unsigned* bar, unsigned x, unsigned& nloc, unsigned& nx) {
    const unsigned G = gridDim.x * gridDim.y * gridDim.z;
    unsigned sum, cnt, mine, sp = 0u;
    for (;;) {
        sum = 0u; cnt = 0u; mine = 0u;
#pragma unroll
        for (unsigned j = 0; j < 16; ++j) { const unsigned c = xb_ld(&bar[XB_XCNT(j)]); sum += c; cnt += (c > 0u) ? 1u : 0u; mine = (j == x) ? c : mine; }
        if (sum == G) break;
        __builtin_amdgcn_s_sleep(1);
        if ((++sp & 255u) == 0u) { if (xb_ld(&bar[XB_TMO])) break; if (sp > XB_SPIN_CAP) { atomicAdd(&bar[XB_TMO], 1u); break; } }
    }
    nloc = mine > 0u ? mine : 1u; nx = cnt > 0u ? cnt : 1u;
}
__device__ __forceinline__ void xcd_barrier(const XcdBarrier& b) {
    asm volatile("s_waitcnt vmcnt(0)" ::: "memory");
    __syncthreads();
    if (threadIdx.x == 0) {
        unsigned* bar = b.bar;
        __builtin_amdgcn_s_waitcnt(0);
        unsigned nloc = b.st[0], nx = b.st[1];
        if (nloc == 0u) { xcd_barrier_complete(bar, b.x, nloc, nx); b.st[0] = nloc; b.st[1] = nx; }
        const unsigned old = xb_add(&bar[XB_XSUB(b.x)], 1u);
        const unsigned gen = old / nloc;
        if (old + 1u == (gen + 1u) * nloc) {
            __builtin_amdgcn_fence(__ATOMIC_RELEASE, "agent");
            asm volatile("s_waitcnt vmcnt(0)" ::: "memory");
            const unsigned og = xb_add(&bar[XB_TOP], 1u);
            const unsigned tg = og / nx;
            if (og + 1u == (tg + 1u) * nx) xb_add(&bar[XB_TOPGEN], 1u);
            else XB_SPIN(xb_ld(&bar[XB_TOPGEN]) == tg, bar);
            __builtin_amdgcn_fence(__ATOMIC_ACQUIRE, "agent");
            xb_add(&bar[XB_XGEN(b.x)], 1u);
            asm volatile("s_waitcnt vmcnt(0)" ::: "memory");
        } else {
            XB_SPIN(xb_ld(&bar[XB_XGEN(b.x)]) == gen, bar);
            __builtin_amdgcn_fence(__ATOMIC_ACQUIRE, "agent");
            asm volatile("s_waitcnt vmcnt(0)" ::: "memory");
        }
    }
    __syncthreads();
}

#ifndef PHASE_SEQ
#define PHASE_SEQ 0, 1, 2, 3, 4, 5, 6, 7, 8, 9, 10, 11, 12, 13, 14, 15, 16, 17, 18, 19, 20
#endif
constexpr int SEQ_HOST[] = {PHASE_SEQ};
constexpr int NPHASE = sizeof(SEQ_HOST) / sizeof(int);
__device__ __forceinline__ int SEQ_AT(int si) { constexpr int t[] = {PHASE_SEQ}; int r = t[0];
#pragma unroll
    for (int i = 1; i < NPHASE; ++i) r = (si == i) ? t[i] : r;
    return r; }
__global__ void __launch_bounds__(NTHR, 2) fwd_kernel(Params p) {
    extern __shared__ __attribute__((aligned(16))) unsigned char shm[];
    LAS unsigned char* lds = (LAS unsigned char*)shm;
    cg::grid_group grid = cg::this_grid();
    __shared__ uint4 xb_words;
    if (threadIdx.x == 0) xb_words = make_uint4(0u, 0u, 0u, 0u);
    __syncthreads();
    XcdBarrier xbar = xcd_barrier_post((unsigned*)(LP(ws) + WS_BAR), (volatile LAS unsigned*)&xb_words);
    const int lo = p.ph_lo, hi = p.ph_hi, G = gridDim.x;
    enum { K_PREP, K_FFN_IN, K_RES, K_HGRN_IN, K_GLA1, K_GLA2, K_GLA3, K_RG_IN, K_CONV, K_GATE, K_SCAN1, K_SCAN3, K_FINAL };
    for (int si = lo; si < hi; ++si) {
        if (si > lo) { if (si == lo + 1) grid.sync(); else xcd_barrier(xbar); }
        int ph = SEQ_AT(si); const bool dup = ph >= 100; if (dup) ph -= 100;
        unsigned char* ws = LP(ws); float* outp = LP(out);
        float* part0 = (float*)(ws + WS_PART); float* part1 = (float*)(ws + WS_PART + SZ_PART);
        float* htail = (float*)(ws + WS_HTAIL); bf16_t* hb = (bf16_t*)(ws + WS_HB);
        const float* oml = (const float*)(ws + WS_VEC); const float* sp = oml + 1024;
        int kind = K_PREP, widx = 0, KK = D; float* pin = part0; float* pout = part1; const bf16_t* Ap = hb; const bf16_t* Wp = nullptr; float sc = 1.0f;
        switch (ph) {
            case 0: kind = K_PREP; break;
            case 1: kind = K_FFN_IN; widx = 0; pin = part0; break;
            case 2: kind = K_RES; Ap = (const bf16_t*)(ws + SC_U); Wp = (const bf16_t*)(ws + W_FFN_OUT + 0 * SZ_FFN_OUT); KK = DFF; pout = part1; sc = 0.5f; break;
            case 3: kind = K_HGRN_IN; pin = part1; break;
            case 4: kind = K_GLA1; break;
            case 5: kind = K_GLA2; break;
            case 6: kind = K_GLA3; break;
            case 7: kind = K_RES; Ap = (const bf16_t*)(ws + SC_G); Wp = (const bf16_t*)(ws + W_A_OUT); KK = D; pout = part0; sc = 1.0f; break;
            case 8: kind = K_FFN_IN; widx = 1; pin = part0; break;
            case 9: kind = K_RES; Ap = (const bf16_t*)(ws + SC_U); Wp = (const bf16_t*)(ws + W_FFN_OUT + 1 * SZ_FFN_OUT); KK = DFF; pout = part1; sc = 0.5f; break;
            case 10: kind = K_FFN_IN; widx = 2; pin = part1; break;
            case 11: kind = K_RES; Ap = (const bf16_t*)(ws + SC_U); Wp = (const bf16_t*)(ws + W_FFN_OUT + 2 * SZ_FFN_OUT); KK = DFF; pout = part0; sc = 0.5f; break;
            case 12: kind = K_RG_IN; pin = part0; break;
            case 13: kind = K_CONV; break;
            case 14: kind = K_GATE; break;
            case 15: kind = K_SCAN1; break;
            case 16: kind = K_SCAN3; break;
            case 17: kind = K_RES; Ap = (const bf16_t*)(ws + SC_GG); Wp = (const bf16_t*)(ws + W_B_OUT); KK = D; pout = part1; sc = 1.0f; break;
            case 18: kind = K_FFN_IN; widx = 3; pin = part1; break;
            case 19: kind = K_RES; Ap = (const bf16_t*)(ws + SC_U); Wp = (const bf16_t*)(ws + W_FFN_OUT + 3 * SZ_FFN_OUT); KK = DFF; pout = part0; sc = 0.5f; break;
            default: kind = K_FINAL; pin = part0; break;
        }
        if (kind == K_PREP) phase_prep(lds);
        else if (kind == K_FFN_IN || kind == K_RES) {
            const bool fold = (G == 256);
            const int cb = obid();
            bool tail_unit = false;
            if (kind == K_FFN_IN) {
                unsigned* tcnt = (unsigned*)(ws + WS_BAR) + 3584 + 128 * widx;
                pg8::Gemm g{hb, (const bf16_t*)(ws + W_FFN_IN + (size_t)widx * SZ_FFN_IN), D, D, D, MP / 256, 2 * DFF / 256}; pg8::StaticOrder S; S.init(g.nM, g.nN, G, cb); if (fold) S.mode = 1;
                EpiFfnIn E{(bf16_t*)(ws + SC_U), pin, fold ? tcnt : nullptr}; pg8::gemm_phase<EpiFfnIn, false>(lds, g, S, E);
                if (fold && cb >= 248) {
                    const int tpm = (cb - 248) >> 2;
                    if (otid() < 64) { unsigned spins = 0;
                        while ((unsigned)__builtin_amdgcn_readfirstlane(__hip_atomic_load(tcnt + 64 * tpm, __ATOMIC_RELAXED, __HIP_MEMORY_SCOPE_AGENT)) < 176u) { __builtin_amdgcn_s_sleep(4); if (++spins > (1u << 22)) break; }
                        __builtin_amdgcn_fence(__ATOMIC_ACQUIRE, "agent"); asm volatile("s_waitcnt vmcnt(0)" ::: "memory"); }
                    __syncthreads();
                    tail_unit = true; Ap = (const bf16_t*)(ws + SC_U); Wp = (const bf16_t*)(ws + W_FFN_OUT + (size_t)widx * SZ_FFN_OUT); KK = DFF; pout = (pin == part0) ? part1 : part0; sc = 0.5f;
                }
            }
            if (kind == K_RES || tail_unit) {
                const bool ffn_out = (KK == DFF);
                pg8::Gemm g{Ap, Wp, KK, KK, KK, (fold && ffn_out) ? 128 : MP / 256, D / 256}; pg8::StaticOrder S; S.init(g.nM, g.nN, G, cb);
                if (tail_unit) { S.mode = 2; S.spm = 128 + ((cb - 248) >> 2); S.spn = (cb - 248) & 3; }
                const int first_res = (!dup && (ph == 2 || (tail_unit && widx == 0))) ? 1 : 0;
                EpiRes E{outp, htail, hb, pout, dup ? 0.0f : sc, LP(x_prompt), LP(x_sample), LP(meta), first_res}; pg8::gemm_phase<EpiRes, false>(lds, g, S, E);
            }
        }
        else if (kind == K_HGRN_IN) { pg8::Gemm g{hb, (const bf16_t*)(ws + W_A_IN), D, D, D, MP / 256, 16}; pg8::StaticOrder S; S.init(g.nM, g.nN, G, obid());
            EpiHgrnIn E{(bf16_t*)(ws + SC_Q), (bf16_t*)(ws + SC_K), (bf16_t*)(ws + SC_V), (bf16_t*)(ws + SC_G), pin, oml}; pg8::gemm_phase<EpiHgrnIn, false>(lds, g, S, E); }
        else if (kind == K_GLA1) phase_gla1(lds);
        else if (kind == K_GLA2) phase_gla2();
        else if (kind == K_GLA3) phase_gla3(lds);
        else if (kind == K_RG_IN) { pg8::Gemm g{hb, (const bf16_t*)(ws + W_B_IN), D, D, D, MP / 256, 8}; pg8::StaticOrder S; S.init(g.nM, g.nN, G, obid());
            EpiRgIn E{(bf16_t*)(ws + SC_XB), (bf16_t*)(ws + SC_GG), pin, outp + O_CP, outp + O_CS}; pg8::gemm_phase<EpiRgIn, false>(lds, g, S, E); }
        else if (kind == K_CONV) phase_conv();
        else if (kind == K_GATE) { int kg = 128; asm volatile("" : "+s"(kg)); pg8::Gemm g{(const bf16_t*)(ws + SC_CF), (const bf16_t*)(ws + W_G), D, kg, kg, MP / 256, 8}; pg8::StaticOrder S; S.init(g.nM, g.nN, G, obid());
            EpiGate E{nullptr, (const bf16_t*)(ws + SC_CF), (bf16_t*)(ws + SC_OM), (bf16_t*)(ws + SC_UU), LP(b_ba), LP(b_bx), sp}; pg8::gemm_phase<EpiGate, true>(lds, g, S, E); }
        else if (kind == K_SCAN1) phase_scan1();
        else if (kind == K_SCAN3) phase_scan3();
        else phase_final(pin);
    }
}

extern "C" void kernel_launch(void* const* d_in, const int* in_sizes, int n_in, void* d_out, int out_size, void* d_ws, size_t ws_size, hipStream_t stream) {
    static int grid = 0;
    constexpr int LDS_BYTES = pg8::STAGE_BYTES + 16384;
    if (grid == 0) {
        if (n_in != 24 || ws_size < WS_TOTAL) { fprintf(stderr, "kernel_launch: unexpected n_in %d or workspace %zu < %zu\n", n_in, ws_size, (size_t)WS_TOTAL); grid = -1; return; }
        if (hipFuncSetAttribute((const void*)fwd_kernel, hipFuncAttributeMaxDynamicSharedMemorySize, LDS_BYTES) != hipSuccess) { fprintf(stderr, "kernel_launch: hipFuncSetAttribute failed\n"); grid = -1; return; }
        int dev = 0, cus = 0, per_cu = 0;
        hipGetDevice(&dev); hipDeviceGetAttribute(&cus, hipDeviceAttributeMultiprocessorCount, dev);
        hipOccupancyMaxActiveBlocksPerMultiprocessor(&per_cu, (const void*)fwd_kernel, NTHR, LDS_BYTES);
        if (per_cu < 1) { fprintf(stderr, "kernel_launch: occupancy query says %d blocks per CU\n", per_cu); per_cu = 1; }
        (void)hipGetLastError();
        grid = cus;
    }
    if (grid < 0) return;
    Params p{};
    const float** f = (const float**)&p;
    for (int i = 0; i < 24; ++i) f[i] = (const float*)d_in[i];
    p.out = (float*)d_out; p.ws = (unsigned char*)d_ws;
#if MK_FUSED
    if (hipMemsetAsync((char*)d_ws + WS_BAR, 0, 16384 + 65536, stream) != hipSuccess) { fprintf(stderr, "kernel_launch: hipMemsetAsync failed\n"); return; }
    p.ph_lo = 0; p.ph_hi = NPHASE;
    void* args[] = {&p};
    hipError_t e = hipLaunchCooperativeKernel((const void*)fwd_kernel, dim3(grid), dim3(NTHR), args, LDS_BYTES, stream);
    if (e != hipSuccess) fprintf(stderr, "cooperative launch failed: %s (grid %d)\n", hipGetErrorString(e), grid);
#else
    for (int k = 0; k < NPHASE; ++k) { p.ph_lo = k; p.ph_hi = k + 1; hipLaunchKernelGGL(fwd_kernel, dim3(grid), dim3(NTHR), LDS_BYTES, stream, p); }
#endif
}
```

```cpp
#include <hip/hip_runtime.h>
#include <hip/hip_cooperative_groups.h>
#include <cstdio>
#include <cstddef>
namespace cg = cooperative_groups;

#ifndef PHASE_MASK
#define PHASE_MASK 0x1FFFFF
#endif
#ifndef MK_FUSED
#define MK_FUSED 1
#endif

#define LAS __attribute__((address_space(3)))
typedef unsigned short bf16_t;
typedef short bf16x8 __attribute__((ext_vector_type(8)));
typedef float f32x4 __attribute__((ext_vector_type(4)));
typedef float f32x2 __attribute__((ext_vector_type(2)));
typedef unsigned u32x4 __attribute__((ext_vector_type(4)));
typedef unsigned u32x2 __attribute__((ext_vector_type(2)));

constexpr int D = 1024, DFF = 2816, NTHR = 512;
constexpr int MP = 33280;
constexpr int ROW_SAMPLE = 32768;
constexpr int ROW_META = 33024;
constexpr int ROW_PAD = 33088;
constexpr int NCH = 33;
constexpr int RCH = 129;
constexpr float EPS = 1e-6f;

constexpr size_t O_YP = 0, O_YS = 33554432, O_HP = 33816576, O_HS = O_HP + 524288, O_RP = O_HS + 2097152, O_RS = O_RP + 4096,
                 O_CP = O_RS + 16384, O_CS = O_CP + 12288;
constexpr size_t SZ_ACT = (size_t)MP * D * 2;
constexpr size_t W_FFN_IN = 0, SZ_FFN_IN = (size_t)2 * DFF * D * 2;
constexpr size_t W_FFN_OUT = W_FFN_IN + 4 * SZ_FFN_IN, SZ_FFN_OUT = (size_t)D * DFF * 2;
constexpr size_t W_A_IN = W_FFN_OUT + 4 * SZ_FFN_OUT;
constexpr size_t W_A_OUT = W_A_IN + (size_t)4096 * D * 2;
constexpr size_t W_B_IN = W_A_OUT + (size_t)D * D * 2;
constexpr size_t W_B_OUT = W_B_IN + (size_t)2048 * D * 2;
constexpr size_t W_G = W_B_OUT + (size_t)D * D * 2;
constexpr size_t WS_VEC = W_G + (size_t)8 * 256 * 256 * 2;
constexpr size_t WS_HB = WS_VEC + 8192;
constexpr size_t WS_PART = WS_HB + SZ_ACT, SZ_PART = (size_t)MP * 16 * 4;
constexpr size_t WS_HTAIL = WS_PART + 2 * SZ_PART;
constexpr size_t WS_SCR = WS_HTAIL + (size_t)256 * D * 4;
constexpr size_t SC_U = WS_SCR;
constexpr size_t SC_Q = WS_SCR, SC_K = SC_Q + SZ_ACT, SC_V = SC_K + SZ_ACT, SC_G = SC_V + SZ_ACT, SC_SST = SC_G + SZ_ACT,
                 SC_DC = SC_SST + (size_t)4 * 8 * NCH * 16384 * 4, SC_END1 = SC_DC + (size_t)4 * 8 * NCH * 128 * 4;
constexpr size_t SC_XB = WS_SCR, SC_GG = SC_XB + SZ_ACT, SC_CF = SC_GG + SZ_ACT, SC_OM = SC_CF + SZ_ACT, SC_UU = SC_OM + SZ_ACT,
                 SC_AB = SC_UU + SZ_ACT, SC_END2 = SC_AB + (size_t)4 * RCH * 1024 * 2 * 4;
constexpr size_t WS_END = (SC_END1 > SC_END2 ? SC_END1 : SC_END2);
static_assert((size_t)MP * DFF * 2 <= SC_END1 - WS_SCR, "U fits");
constexpr size_t WS_BAR = (WS_END + 255) / 256 * 256, WS_ZERO = WS_BAR + 16384, WS_TOTAL = WS_ZERO + 65536;
static_assert(WS_TOTAL <= (size_t)536870912, "workspace budget");

struct Params {
    const float *x_prompt, *x_sample, *state_hgrn, *state_rglru, *state_conv, *meta, *ffn_norm, *ffn_w_in, *ffn_w_out, *mix_norm,
        *a_w_in, *a_lb, *a_onorm, *a_w_out, *b_w_in, *b_conv_w, *b_conv_b, *b_wa, *b_ba, *b_wx, *b_bx, *b_lambda, *b_w_out, *final_norm;
    float* out; unsigned char* ws; int ph_lo, ph_hi;
};

typedef __bf16 bf16x2v_ __attribute__((ext_vector_type(2)));
__device__ __forceinline__ unsigned cvt_pk_bf16(float lo, float hi) { const f32x2 v = {lo, hi}; return __builtin_bit_cast(unsigned, __builtin_convertvector(v, bf16x2v_)); }
__device__ __forceinline__ float bf_lo(unsigned w) { return __uint_as_float(w << 16); }
__device__ __forceinline__ float bf_hi(unsigned w) { return __uint_as_float(w & 0xffff0000u); }
__device__ __forceinline__ float bf2f(bf16_t b) { return __uint_as_float(((unsigned)b) << 16); }
__device__ __forceinline__ float sigmoidf_(float x) { return __builtin_amdgcn_rcpf(1.0f + __expf(-x)); }
__device__ __forceinline__ float siluf_(float x) { return x * sigmoidf_(x); }
__device__ __forceinline__ float gelu_tanh(float x) { const float t = 1.5957691216f * (x + 0.044715f * x * x * x); return x * sigmoidf_(t); }
__device__ __forceinline__ float* hrow(float* hmain, float* htail, int row) { return row < ROW_META ? hmain + (size_t)row * D : htail + (size_t)(row - ROW_META) * D; }
#define GASP __attribute__((address_space(1)))
__device__ __forceinline__ void gst16(void* p, u32x4 v) { *(GASP u32x4*)(GASP void*)p = v; }
__device__ __forceinline__ void gst8u(void* p, u32x2 v) { *(GASP u32x2*)(GASP void*)p = v; }
__device__ __forceinline__ void gst16f(void* p, f32x4 v) { *(GASP f32x4*)(GASP void*)p = v; }
__device__ __forceinline__ f32x4 gld16f(const void* p) { return *(const GASP f32x4*)(const GASP void*)p; }
__device__ __forceinline__ float* hrow2(float* hmain, float* htail, int row) {
    const long long d = (long long)((const char*)htail - (const char*)hmain) - (long long)ROW_META * D * 4;
    return (float*)((char*)hmain + (size_t)row * D * 4 + (row >= ROW_META ? d : 0ll)); }

__device__ __forceinline__ unsigned long long karg(int i) { const __attribute__((address_space(4))) unsigned long long* ka = (const __attribute__((address_space(4))) unsigned long long*)__builtin_amdgcn_kernarg_segment_ptr(); asm volatile("" : "+s"(ka)); return ka[i]; }
#define LP(f) ((decltype(Params::f))karg((int)(offsetof(Params, f) / 8)))
#define LOADP(f) p.f = LP(f)
__device__ __forceinline__ float shx(float v, int o, int lane) { return __int_as_float(__builtin_amdgcn_ds_bpermute((lane ^ o) << 2, __float_as_int(v))); }
__device__ __forceinline__ int otid() { int t = threadIdx.x; asm volatile("" : "+v"(t)); return t; }
__device__ __forceinline__ int obid() { int b = blockIdx.x; asm volatile("" : "+s"(b)); return b; }
namespace pg8 {
constexpr int BM = 256, BK = 64, HALF = 128, HTB = HALF * BK * 2, STAGE_BYTES = 8 * HTB, NXCD = 8, WGM = 8;
__host__ __device__ __forceinline__ int lds_byte(int r, int c) { const int st = (r >> 4) * 2 + (c >> 5), rr = r & 15, cc = c & 31, ob = rr * 64 + cc * 2; return st * 1024 + (ob ^ (((ob >> 9) & 1) << 5)); }
__host__ __device__ __forceinline__ void stage_rc(int b, int& R, int& C) { const int st = b / 1024, sb = b % 1024, swz = sb ^ (((sb >> 9) & 1) << 5); R = (st >> 1) * 16 + swz / 64; C = (st & 1) * 32 + (swz % 64) / 2; }
__host__ __device__ __forceinline__ int perm32(int rho) { const int n = rho >> 4, i = rho & 15; return 8 * (i >> 2) + 4 * n + (i & 3); }
struct Unit { int pm, pn; };
struct Gemm { const bf16_t* A; const bf16_t* Bt; int lda, ldb, K, nM, nN; };
struct StaticOrder {
    int nM, nN, nwg, G, c, mode, spm, spn;
    __device__ void init(int nM_, int nN_, int G_, int c_) { nM = nM_; nN = nN_; nwg = nM * nN; G = G_; c = c_; mode = 0; spm = 0; spn = 0; }
    __device__ bool next(int i, Unit& u) const {
        if (mode == 2) { if (i > 0) return false; u.pm = spm; u.pn = spn; return true; }
        long L;
        if (mode == 1) {
            if (c >= 248) { if (i >= 9) return false; L = (long)i * 256 + c; }
            else if (c >= 44 && c < 60) { if (i < 11) L = (long)i * 256 + c; else if (i == 11) L = 2304 + 256 * ((c - 44) >> 3) + 248 + ((c - 44) & 7); else return false; }
            else { L = (long)i * 256 + c; if (L >= 2860) return false; }
            if (L < 44) { u.pm = 128 + ((int)L & 1); u.pn = (int)L >> 1; return true; }
            L -= 44;
            int wgid = (int)L; { const int q = 2816 / NXCD, xcd = wgid % NXCD, off = wgid / NXCD; wgid = xcd * q + off; }
            const int nig = WGM * 22, gid = wgid / nig; u.pm = gid * WGM + ((wgid % nig) % WGM); u.pn = (wgid % nig) / WGM; return true;
        }
        L = (long)i * G + c; if (L >= nwg) return false;
        int wgid = (int)L; { const int q = nwg / NXCD, r = nwg % NXCD, xcd = wgid % NXCD, off = wgid / NXCD; wgid = (xcd < r ? xcd * (q + 1) : r * (q + 1) + (xcd - r) * q) + off; }
        const int nig = WGM * nN, gid = wgid / nig, fm = gid * WGM, gsz = (nM - fm) < WGM ? (nM - fm) : WGM;
        u.pm = fm + ((wgid % nig) % gsz); u.pn = (wgid % nig) / gsz; return true;
    }
};

template <class Epi, bool AKOFF>
__device__ __forceinline__ void gemm_phase(LAS unsigned char* lds, const Gemm g, const StaticOrder& S, const Epi& E) {
    int tid_ = otid();
    const int tid = tid_, wid = __builtin_amdgcn_readfirstlane(tid >> 6), lane = tid & 63, wr = wid >> 2, wc = wid & 3, fr = lane & 15, fq = lane >> 4;
    const int K = g.K, nt = K / BK;
    unsigned voffA[2], voffB[2];
#pragma unroll
    for (int i = 0; i < 2; ++i) { int R, C; stage_rc(tid * 16 + i * 8192, R, C); const int Rb = Epi::PERM ? ((R & ~31) + perm32(R & 31)) : R;
        voffA[i] = (unsigned)(R * g.lda + C) * 2u; voffB[i] = (unsigned)(Rb * g.ldb + C) * 2u; }
    const size_t kstep = (size_t)(BK * 2);
    const size_t hstepA = (size_t)HALF * g.lda * 2, hstepB = (size_t)HALF * g.ldb * 2;
    const unsigned ldsw = (unsigned)wid * 1024u;
    const int aoff = lds_byte(wr * 64 + fr, fq * 8), boff = lds_byte(wc * 32 + fr, fq * 8);
#define PG8_SA(b, h) (((b) * 2 + (h)) * HTB)
#define PG8_SB(b, h) ((4 + (b) * 2 + (h)) * HTB)
#define PG8_STAGE(bufoff, gbase, voff) do { _Pragma("unroll") for (int _i = 0; _i < 2; ++_i) \
        __builtin_amdgcn_global_load_lds((const unsigned*)((const char*)(gbase) + (voff)[_i]), (LAS unsigned*)(lds + (bufoff) + ldsw + _i * 8192), 16, 0, 0); } while (0)
#define PG8_LDA(dst, b, h) do { _Pragma("unroll") for (int m = 0; m < 4; ++m) _Pragma("unroll") for (int k = 0; k < 2; ++k) dst[m][k] = *(const LAS bf16x8*)(lds + PG8_SA(b, h) + aoff + m * 2048 + k * 1024); } while (0)
#define PG8_LDB(dst, b, h) do { _Pragma("unroll") for (int n = 0; n < 2; ++n) _Pragma("unroll") for (int k = 0; k < 2; ++k) dst[n][k] = *(const LAS bf16x8*)(lds + PG8_SB(b, h) + boff + n * 2048 + k * 1024); } while (0)
#define PG8_MMA(ai, bj, At, Bt) do { __builtin_amdgcn_s_setprio(1); _Pragma("unroll") for (int m = 0; m < 4; ++m) _Pragma("unroll") for (int n = 0; n < 2; ++n) _Pragma("unroll") for (int k = 0; k < 2; ++k) \
        acc[ai][bj][m][n] = __builtin_amdgcn_mfma_f32_16x16x32_bf16(Bt[n][k], At[m][k], acc[ai][bj][m][n], 0, 0, 0); __builtin_amdgcn_s_setprio(0); } while (0)
#define PG8_WAIT_V(n) asm volatile("s_waitcnt vmcnt(" #n ")" ::: "memory")
#define PG8_WAIT_L(n) asm volatile("s_waitcnt lgkmcnt(" #n ")" ::: "memory")
#define PG8_BAR __builtin_amdgcn_s_barrier()
#define PG8_SCHED __builtin_amdgcn_sched_barrier(0)
#define PG8_UA(u) ((const char*)g.A + ((size_t)(u).pm * BM * g.lda + (AKOFF ? (size_t)128 * (u).pn : (size_t)0)) * 2)
#define PG8_UB(u) ((const char*)g.Bt + (size_t)(u).pn * BM * g.ldb * 2)
    Unit cur, nxt; int ui = 0;
    if (!S.next(0, cur)) return;
    f32x4 acc[2][2][4][2];
#pragma unroll
    for (int a = 0; a < 2; ++a)
#pragma unroll
        for (int b = 0; b < 2; ++b)
#pragma unroll
            for (int m = 0; m < 4; ++m)
#pragma unroll
                for (int n = 0; n < 2; ++n) acc[a][b][m][n] = (f32x4){0.f, 0.f, 0.f, 0.f};
    bf16x8 At[4][2], B0[2][2], B1[2][2];
    const char* cA = PG8_UA(cur); const char* cB = PG8_UB(cur);
    PG8_STAGE(PG8_SB(0, 0), cB, voffB); PG8_STAGE(PG8_SA(0, 0), cA, voffA); PG8_STAGE(PG8_SB(0, 1), cB + hstepB, voffB); PG8_STAGE(PG8_SA(0, 1), cA + hstepA, voffA);
    if (wr == 1) PG8_BAR;
    PG8_WAIT_V(4); PG8_BAR;
    PG8_STAGE(PG8_SB(1, 0), cB + kstep, voffB); PG8_STAGE(PG8_SA(1, 0), cA + kstep, voffA); PG8_STAGE(PG8_SB(1, 1), cB + hstepB + kstep, voffB);
    PG8_WAIT_V(6); PG8_BAR;
    for (;;) {
        if (Epi::PARTPF) {
            if (ui > 0) { PG8_BAR; PG8_BAR; }
            unsigned pvo = (unsigned)(tid & 63) * 16u + (unsigned)wid * 2048u; asm volatile("" : "+v"(pvo));
            const char* psrc = (const char*)E.part + (size_t)cur.pm * (256 * 64);
            _Pragma("unroll") for (int _i = 0; _i < 2; ++_i)
                __builtin_amdgcn_global_load_lds((const unsigned*)(psrc + pvo + _i * 1024), (LAS unsigned*)(lds + STAGE_BYTES + wid * 2048 + _i * 1024), 16, 0, 0);
        }
        const bool has_next = S.next(ui + 1, nxt);
        const char* nA = has_next ? PG8_UA(nxt) : cA; const char* nB = has_next ? PG8_UB(nxt) : cB;
        for (int t = 0; t < nt; t += 2) {
            const bool last = (t == nt - 2);
            const char* a1 = cA + (size_t)(t + 1) * kstep;
            const char* a2 = last ? nA : cA + (size_t)(t + 2) * kstep; const char* b2 = last ? nB : cB + (size_t)(t + 2) * kstep;
            const char* a3 = a2 + kstep; const char* b3 = b2 + kstep;
            PG8_LDB(B0, 0, 0); PG8_SCHED; PG8_LDA(At, 0, 0); PG8_STAGE(PG8_SA(1, 1), a1 + hstepA, voffA);
            PG8_WAIT_L(8); PG8_BAR; PG8_WAIT_L(0); PG8_MMA(0, 0, At, B0); PG8_BAR; PG8_SCHED;
            PG8_LDB(B1, 0, 1); PG8_STAGE(PG8_SB(0, 0), b2, voffB);
            PG8_BAR; PG8_WAIT_L(0); PG8_MMA(0, 1, At, B1); PG8_BAR;
            PG8_LDA(At, 0, 1); PG8_STAGE(PG8_SA(0, 0), a2, voffA);
            PG8_BAR; PG8_WAIT_L(0); PG8_MMA(1, 0, At, B0); PG8_BAR; PG8_SCHED;
            PG8_STAGE(PG8_SB(0, 1), b2 + hstepB, voffB);
            PG8_WAIT_V(6); PG8_BAR; PG8_MMA(1, 1, At, B1); PG8_BAR;
            PG8_LDB(B0, 1, 0); PG8_SCHED; PG8_LDA(At, 1, 0); PG8_STAGE(PG8_SA(0, 1), a2 + hstepA, voffA);
            PG8_WAIT_L(8); PG8_BAR; PG8_WAIT_L(0); PG8_MMA(0, 0, At, B0); PG8_BAR; PG8_SCHED;
            PG8_LDB(B1, 1, 1); PG8_STAGE(PG8_SB(1, 0), b3, voffB);
            PG8_BAR; PG8_WAIT_L(0); PG8_MMA(0, 1, At, B1); PG8_BAR;
            PG8_LDA(At, 1, 1); PG8_STAGE(PG8_SA(1, 0), a3, voffA);
            PG8_BAR; PG8_WAIT_L(0); PG8_MMA(1, 0, At, B0); PG8_BAR; PG8_SCHED;
            PG8_STAGE(PG8_SB(1, 1), b3 + hstepB, voffB);
            PG8_WAIT_V(6); PG8_BAR; PG8_MMA(1, 1, At, B1); PG8_BAR;
        }
        E(acc, cur, wr, wc, fr, fq, lds);
        if (!has_next) break;
#pragma unroll
        for (int a = 0; a < 2; ++a)
#pragma unroll
            for (int b = 0; b < 2; ++b)
#pragma unroll
                for (int m = 0; m < 4; ++m)
#pragma unroll
                    for (int n = 0; n < 2; ++n) { f32x2 z0, z1; asm volatile("v_mov_b64 %0, 0\n\tv_mov_b64 %1, 0" : "=v"(z0), "=v"(z1)); acc[a][b][m][n] = (f32x4){z0[0], z0[1], z1[0], z1[1]}; }
        cur = nxt; cA = nA; cB = nB; ++ui;
    }
    PG8_WAIT_V(0);
    if (wr == 0) PG8_BAR;
    PG8_BAR;
#undef PG8_SA
#undef PG8_SB
#undef PG8_STAGE
#undef PG8_LDA
#undef PG8_LDB
#undef PG8_MMA
#undef PG8_WAIT_V
#undef PG8_WAIT_L
#undef PG8_BAR
#undef PG8_SCHED
#undef PG8_UA
#undef PG8_UB
}
}
using pg8::Unit;
typedef f32x4 Acc[2][2][4][2];

__device__ __forceinline__ float row_rstd(const float* part, int row, int fr, int fq) {
    const f32x4 p = *(const f32x4*)(part + (size_t)row * 16 + 4 * fq);
    float s = (p[0] + p[1]) + (p[2] + p[3]);
    const int lane = (fq << 4) | fr; s += shx(s, 16, lane); s += shx(s, 32, lane);
    return rsqrtf(s * (1.0f / 1024.0f) + EPS);
}

__device__ __forceinline__ void rows_rstd8_lds(const LAS unsigned char* pl, int rl0, int fr, int fq, float (&rs)[8]) {
    float mine[2];
#pragma unroll
    for (int k = 0; k < 2; ++k) {
        const int r = 2 * fq + k; const LAS unsigned char* rp = pl + (rl0 + (r >> 2) * 128 + (r & 3) * 16) * 64;
        const f32x4 p0 = *(const LAS f32x4*)(rp), p1 = *(const LAS f32x4*)(rp + 16), p2 = *(const LAS f32x4*)(rp + 32), p3 = *(const LAS f32x4*)(rp + 48);
        const f32x4 q = (p0 + p1) + (p2 + p3);
        mine[k] = __builtin_amdgcn_rsqf(((q[0] + q[1]) + (q[2] + q[3])) * (1.0f / 1024.0f) + EPS);
    }
#pragma unroll
    for (int q = 0; q < 4; ++q) {
        rs[2 * q] = __int_as_float(__builtin_amdgcn_ds_bpermute(((q << 4) | fr) << 2, __float_as_int(mine[0])));
        rs[2 * q + 1] = __int_as_float(__builtin_amdgcn_ds_bpermute(((q << 4) | fr) << 2, __float_as_int(mine[1])));
    }
}
__device__ __forceinline__ void rows_rstd8(const float* part, int row0, int fr, int fq, float (&rs)[8]) {
    f32x4 pv[8];
#pragma unroll
    for (int r = 0; r < 8; ++r) pv[r] = *(const f32x4*)(part + (size_t)(row0 + (r >> 2) * 128 + (r & 3) * 16) * 16 + 4 * fq);
    const int lane = (fq << 4) | fr;
#pragma unroll
    for (int r = 0; r < 8; ++r) { float s_ = (pv[r][0] + pv[r][1]) + (pv[r][2] + pv[r][3]); s_ += shx(s_, 16, lane); s_ += shx(s_, 32, lane); rs[r] = rsqrtf(s_ * (1.0f / 1024.0f) + EPS); }
}
struct EpiFfnIn {
    static constexpr bool PERM = true, PARTPF = true;
    bf16_t* U; const float* part; unsigned* cnt;
    __device__ __forceinline__ void operator()(const Acc& acc, const Unit& u, int wr, int wc, int fr, int fq, LAS unsigned char* lds) const {
        const int row0 = u.pm * 256 + wr * 64 + fr, col0 = u.pn * 128 + wc * 32 + 8 * fq;
        float rsv[8]; rows_rstd8_lds(lds + pg8::STAGE_BYTES, wr * 64 + fr, fr, fq, rsv);
#pragma unroll
        for (int ai = 0; ai < 2; ++ai)
#pragma unroll
            for (int m = 0; m < 4; ++m) {
                const int row = row0 + ai * 128 + m * 16; const float rs = rsv[ai * 4 + m];
                const float rsn = rs * -1.4426950409f, rs2 = rs * rs; unsigned wv[4];
#pragma unroll
                for (int n = 0; n < 2; ++n)
#pragma unroll
                    for (int e2 = 0; e2 < 2; ++e2) {
                        const f32x2 a = {acc[ai][0][m][n][2 * e2], acc[ai][0][m][n][2 * e2 + 1]}, b = {acc[ai][1][m][n][2 * e2], acc[ai][1][m][n][2 * e2 + 1]};
                        const f32x2 arg = a * rsn;
                        f32x2 d; d.x = __builtin_amdgcn_exp2f(arg.x); d.y = __builtin_amdgcn_exp2f(arg.y); d = d + 1.0f;
                        f32x2 r; r.x = __builtin_amdgcn_rcpf(d.x); r.y = __builtin_amdgcn_rcpf(d.y);
                        const f32x2 o2 = ((a * b) * r) * rs2;
                        wv[n * 2 + e2] = cvt_pk_bf16(o2.x, o2.y); }
                u32x4 w; w.x = wv[0]; w.y = wv[1]; w.z = wv[2]; w.w = wv[3];
                gst16(U + (size_t)row * DFF + col0, w);
            }
        if (cnt && u.pm >= 128) {
            asm volatile("s_waitcnt vmcnt(0)" ::: "memory");
            __builtin_amdgcn_fence(__ATOMIC_RELEASE, "agent");
            asm volatile("s_waitcnt vmcnt(0)" ::: "memory");
            if (fr == 0 && fq == 0) __hip_atomic_fetch_add(cnt + 64 * (u.pm - 128), 1u, __ATOMIC_RELAXED, __HIP_MEMORY_SCOPE_AGENT);
        }
    }
};
struct EpiRes {
    static constexpr bool PERM = true, PARTPF = false;
    float* hmain; float* htail; bf16_t* hb; float* part; float scale; const float *xp, *xs, *xm; int first;
    __device__ __forceinline__ const float* rsrc(int row) const {
        if (!first) return hrow2(hmain, htail, row);
        const char* b0 = (const char*)xp + (size_t)row * (D * 4);
        const char* b1 = (const char*)xs + (size_t)(row - ROW_SAMPLE) * (D * 4);
        const char* b2 = (const char*)xm + (size_t)((row - ROW_META) & 15) * (D * 4);
        return (const float*)(row < ROW_SAMPLE ? b0 : (row < ROW_META ? b1 : b2));
    }
    __device__ __forceinline__ void operator()(const Acc& acc, const Unit& u, int wr, int wc, int fr, int fq, LAS unsigned char* lds) const {
        const int row0 = u.pm * 256 + wr * 64 + fr, col0 = u.pn * 256 + wc * 32 + 8 * fq, lane = (fq << 4) | fr;
#pragma unroll
        for (int ai = 0; ai < 2; ++ai) {
            f32x4 x[4][2][2];
#pragma unroll
            for (int m = 0; m < 4; ++m) { const int rr = row0 + ai * 128 + m * 16; const float* hp = rsrc(rr) + col0; const float keep = (first && rr >= ROW_PAD) ? 0.f : 1.f;
#pragma unroll
                for (int bj = 0; bj < 2; ++bj)
#pragma unroll
                    for (int n = 0; n < 2; ++n) x[m][bj][n] = gld16f(hp + bj * 128 + n * 4) * keep; }
#pragma unroll
            for (int m = 0; m < 4; ++m) {
                const int row = row0 + ai * 128 + m * 16; float* hp = hrow2(hmain, htail, row) + col0; bf16_t* bp = hb + (size_t)row * D + col0; float ss = 0.f;
#pragma unroll
                for (int bj = 0; bj < 2; ++bj) {
                    const f32x4 v0 = x[m][bj][0] + acc[ai][bj][m][0] * scale, v1 = x[m][bj][1] + acc[ai][bj][m][1] * scale;
                    gst16f(hp + bj * 128, v0); gst16f(hp + bj * 128 + 4, v1);
                    ss += ((v0[0] * v0[0] + v0[1] * v0[1]) + (v0[2] * v0[2] + v0[3] * v0[3])) + ((v1[0] * v1[0] + v1[1] * v1[1]) + (v1[2] * v1[2] + v1[3] * v1[3]));
                    u32x4 w; w.x = cvt_pk_bf16(v0[0], v0[1]); w.y = cvt_pk_bf16(v0[2], v0[3]); w.z = cvt_pk_bf16(v1[0], v1[1]); w.w = cvt_pk_bf16(v1[2], v1[3]);
                    gst16(bp + bj * 128, w); }
                ss += shx(ss, 16, lane); ss += shx(ss, 32, lane);
                if (fq == 0) part[(size_t)row * 16 + 4 * u.pn + wc] = ss;
            }
            asm volatile("" ::: "memory");
        }
    }
};
template <int ACT>
__device__ __forceinline__ void inproj_store(const Acc& acc, bf16_t* dst, int row0, int col0, const float (&rsv)[8], const float (&ol)[2][8], float* const (&cdst)[8]) {
#pragma unroll
    for (int ai = 0; ai < 2; ++ai)
#pragma unroll
        for (int m = 0; m < 4; ++m) {
            const int row = row0 + ai * 128 + m * 16; const float rs = rsv[ai * 4 + m];
#pragma unroll
            for (int bj = 0; bj < 2; ++bj) {
                float o[8];
#pragma unroll
                for (int n = 0; n < 2; ++n)
#pragma unroll
                    for (int e2 = 0; e2 < 2; ++e2) {
                        const f32x2 a2 = {acc[ai][bj][m][n][2 * e2], acc[ai][bj][m][n][2 * e2 + 1]}; f32x2 o2;
                        if (ACT == 0) o2 = a2 * rs;
                        else {
                            f32x2 arg, x = a2 * rs;
                            if (ACT == 1) arg = a2 * (rs * -1.4426950409f);
                            else if (ACT == 2) arg = a2 * (rs * 1.4426950409f);
                            else { const f32x2 x2 = x * x; arg = (x * (-1.4426950409f * 1.5957691216f)) * (x2 * 0.044715f + 1.0f); }
                            f32x2 d; d.x = __builtin_amdgcn_exp2f(arg.x); d.y = __builtin_amdgcn_exp2f(arg.y); d = d + 1.0f;
                            f32x2 r; r.x = __builtin_amdgcn_rcpf(d.x); r.y = __builtin_amdgcn_rcpf(d.y);
                            if (ACT == 2) { const f32x2 l2 = {ol[bj][n * 4 + 2 * e2], ol[bj][n * 4 + 2 * e2 + 1]}; o2 = l2 * r; } else o2 = x * r;
                        }
                        o[n * 4 + 2 * e2] = o2.x; o[n * 4 + 2 * e2 + 1] = o2.y; }
                u32x4 w; w.x = cvt_pk_bf16(o[0], o[1]); w.y = cvt_pk_bf16(o[2], o[3]); w.z = cvt_pk_bf16(o[4], o[5]); w.w = cvt_pk_bf16(o[6], o[7]);
                gst16(dst + (size_t)row * D + col0 + bj * 128, w);
                if (ACT == 0 && cdst[ai * 4 + m]) { float* cd = cdst[ai * 4 + m]; gst16f(cd + col0 + bj * 128, (f32x4){o[0], o[1], o[2], o[3]}); gst16f(cd + col0 + bj * 128 + 4, (f32x4){o[4], o[5], o[6], o[7]}); }
            }
        }
}
struct EpiHgrnIn {
    static constexpr bool PERM = true, PARTPF = true;
    bf16_t *Q, *KK, *V, *G; const float* part; const float* oml;
    __device__ __forceinline__ void operator()(const Acc& acc, const Unit& u, int wr, int wc, int fr, int fq, LAS unsigned char* lds) const {
        const int region = u.pn >> 2;
        const int row0 = u.pm * 256 + wr * 64 + fr, col0 = (u.pn & 3) * 256 + wc * 32 + 8 * fq;
        float rsv[8]; rows_rstd8_lds(lds + pg8::STAGE_BYTES, wr * 64 + fr, fr, fq, rsv);
        float ol[2][8]; float* cd[8];
#pragma unroll
        for (int r = 0; r < 8; ++r) { cd[r] = nullptr; ol[0][r] = 0.f; ol[1][r] = 0.f; }
        if (region == 0) inproj_store<1>(acc, Q, row0, col0, rsv, ol, cd);
        else if (region == 1) {
#pragma unroll
            for (int bj = 0; bj < 2; ++bj) { const f32x4 a = *(const f32x4*)(oml + col0 + bj * 128), b = *(const f32x4*)(oml + col0 + bj * 128 + 4);
#pragma unroll
                for (int e = 0; e < 4; ++e) { ol[bj][e] = a[e]; ol[bj][4 + e] = b[e]; } }
            inproj_store<2>(acc, KK, row0, col0, rsv, ol, cd);
        }
        else if (region == 2) inproj_store<0>(acc, V, row0, col0, rsv, ol, cd);
        else inproj_store<1>(acc, G, row0, col0, rsv, ol, cd);
    }
};
struct EpiRgIn {
    static constexpr bool PERM = true, PARTPF = true;
    bf16_t *XB, *GG; const float* part; float* conv_p; float* conv_s;
    __device__ __forceinline__ void operator()(const Acc& acc, const Unit& u, int wr, int wc, int fr, int fq, LAS unsigned char* lds) const {
        const int region = u.pn >> 2;
        const int row0 = u.pm * 256 + wr * 64 + fr, col0 = (u.pn & 3) * 256 + wc * 32 + 8 * fq;
        float rsv[8]; rows_rstd8_lds(lds + pg8::STAGE_BYTES, wr * 64 + fr, fr, fq, rsv);
        float ol[2][8]; float* cd[8];
#pragma unroll
        for (int r = 0; r < 8; ++r) { cd[r] = nullptr; ol[0][r] = 0.f; ol[1][r] = 0.f; }
        if (region == 0) {
            if (u.pm == 31 || u.pm == 63 || u.pm == 95 || u.pm >= 127) {
#pragma unroll
                for (int r = 0; r < 8; ++r) { const int row = row0 + (r >> 2) * 128 + (r & 3) * 16;
                    if (row < ROW_SAMPLE) { const int p = row & 8191; if (p >= 8189) cd[r] = conv_p + ((size_t)(row >> 13) * 3 + (p - 8189)) * D; }
                    else if (row < ROW_META) { const int p = row & 15; if (p >= 13) cd[r] = conv_s + ((size_t)((row - ROW_SAMPLE) >> 4) * 3 + (p - 13)) * D; } }
            }
            inproj_store<0>(acc, XB, row0, col0, rsv, ol, cd);
        } else inproj_store<3>(acc, GG, row0, col0, rsv, ol, cd);
    }
};
__device__ __forceinline__ float expm1_fast(float x) {
    const float p = x * (1.0f + x * (0.5f + x * (0.16666667f + x * (0.041666668f + x * (0.0083333338f + x * 0.0013888889f)))));
    return x > -0.25f ? p : __expf(x) - 1.0f;
}
struct EpiGate {
    static constexpr bool PERM = true, PARTPF = false; const float* part;
    const bf16_t* CF; bf16_t *OM, *UU; const float *ba, *bx, *sp;
    __device__ __forceinline__ void operator()(const Acc& acc, const Unit& u, int wr, int wc, int fr, int fq, LAS unsigned char* lds) const {
        const int row0 = u.pm * 256 + wr * 64 + fr, col0 = u.pn * 128 + wc * 32 + 8 * fq;
        constexpr float NL2E = -1.4426950409f;
#pragma unroll
        for (int n = 0; n < 2; ++n) {
            const f32x4 vba = *(const f32x4*)(ba + col0 + 4 * n) * NL2E, vbx = *(const f32x4*)(bx + col0 + 4 * n) * NL2E, vsp = *(const f32x4*)(sp + col0 + 4 * n) * (8.0f * NL2E);
            u32x2 cw[8];
#pragma unroll
            for (int r = 0; r < 8; ++r) cw[r] = *(const u32x2*)(CF + (size_t)(row0 + (r >> 2) * 128 + (r & 3) * 16) * D + col0 + 4 * n);
#pragma unroll
            for (int ai = 0; ai < 2; ++ai)
#pragma unroll
                for (int m = 0; m < 4; ++m) {
                    const size_t off = (size_t)(row0 + ai * 128 + m * 16) * D + col0 + 4 * n;
                    const u32x2 c2 = cw[ai * 4 + m]; unsigned wom[2], wuu[2];
#pragma unroll
                    for (int e2 = 0; e2 < 2; ++e2) {
                        const f32x2 ar = {acc[ai][0][m][n][2 * e2], acc[ai][0][m][n][2 * e2 + 1]}, ax = {acc[ai][1][m][n][2 * e2], acc[ai][1][m][n][2 * e2 + 1]};
                        const f32x2 br = {vba[2 * e2], vba[2 * e2 + 1]}, bxx = {vbx[2 * e2], vbx[2 * e2 + 1]}, sp2 = {vsp[2 * e2], vsp[2 * e2 + 1]};
                        const unsigned cwd = e2 ? c2.y : c2.x; const f32x2 cf = {bf_lo(cwd), bf_hi(cwd)};
                        f32x2 t = ar * NL2E + br; f32x2 d; d.x = __builtin_amdgcn_exp2f(t.x); d.y = __builtin_amdgcn_exp2f(t.y); d = d + 1.0f;
                        f32x2 r; r.x = __builtin_amdgcn_rcpf(d.x); r.y = __builtin_amdgcn_rcpf(d.y);
                        t = ax * NL2E + bxx; d.x = __builtin_amdgcn_exp2f(t.x); d.y = __builtin_amdgcn_exp2f(t.y); d = d + 1.0f;
                        f32x2 ig; ig.x = __builtin_amdgcn_rcpf(d.x); ig.y = __builtin_amdgcn_rcpf(d.y);
                        t = r * sp2; f32x2 ea; ea.x = __builtin_amdgcn_exp2f(t.x); ea.y = __builtin_amdgcn_exp2f(t.y);
                        const f32x2 om = 1.0f - ea;
                        t = om * (ea + 1.0f); f32x2 sq; sq.x = __builtin_amdgcn_sqrtf(t.x); sq.y = __builtin_amdgcn_sqrtf(t.y);
                        const f32x2 uu = (sq * ig) * cf;
                        wom[e2] = cvt_pk_bf16(om.x, om.y); wuu[e2] = cvt_pk_bf16(uu.x, uu.y); }
                    u32x2 w; w.x = wom[0]; w.y = wom[1]; gst8u(OM + off, w);
                    w.x = wuu[0]; w.y = wuu[1]; gst8u(UU + off, w);
                }
            asm volatile("" ::: "memory");
        }
    }
};

__device__ __forceinline__ void convert_tile(const float* src, int ldsrc, int K, const float* gvec, bf16_t* dst, int map, int t, int tid) {
    const int nk = K >> 7, tn = t / nk, tk = t - tn * nk, n0 = tn * 256, k0 = tk * 128 + (tid >> 6) * 16, lane = tid & 63;
    int c0 = n0 + 4 * lane; if (map) { const int pn = n0 >> 8; c0 = (lane < 32 ? 128 * pn + 4 * lane : DFF + 128 * pn + 4 * (lane - 32)); }
    const float* sp_ = src + (size_t)k0 * ldsrc + c0;
    f32x4 v[16];
#pragma unroll
    for (int j = 0; j < 16; ++j) v[j] = gld16f(sp_ + (size_t)j * ldsrc);
    if (gvec) {
#pragma unroll
        for (int j = 0; j < 16; ++j) v[j] *= gvec[k0 + j];
    }
    bf16_t* dp = dst + (size_t)(n0 + 4 * lane) * K + k0;
#pragma unroll
    for (int q = 0; q < 4; ++q) {
        u32x4 w0, w1;
        w0.x = cvt_pk_bf16(v[0][q], v[1][q]); w0.y = cvt_pk_bf16(v[2][q], v[3][q]); w0.z = cvt_pk_bf16(v[4][q], v[5][q]); w0.w = cvt_pk_bf16(v[6][q], v[7][q]);
        w1.x = cvt_pk_bf16(v[8][q], v[9][q]); w1.y = cvt_pk_bf16(v[10][q], v[11][q]); w1.z = cvt_pk_bf16(v[12][q], v[13][q]); w1.w = cvt_pk_bf16(v[14][q], v[15][q]);
        gst16(dp + (size_t)q * K, w0); gst16(dp + (size_t)q * K + 8, w1);
    }
}

__device__ __forceinline__ void phase_prep(LAS unsigned char* lds) { Params p; LOADP(ws); LOADP(out); LOADP(x_prompt); LOADP(x_sample); LOADP(meta); LOADP(a_lb); LOADP(b_lambda); LOADP(b_wa); LOADP(b_wx); LOADP(ffn_w_in); LOADP(ffn_norm); LOADP(ffn_w_out); LOADP(a_w_in); LOADP(mix_norm); LOADP(a_w_out); LOADP(b_w_in); LOADP(b_w_out);
    const int tid = otid(), G = gridDim.x, bid = obid(), lane = tid & 63, wave = tid >> 6;
    unsigned char* ws = p.ws;
    {
        float* hmain = p.out; float* htail = (float*)(ws + WS_HTAIL); bf16_t* hb = (bf16_t*)(ws + WS_HB); float* part = (float*)(ws + WS_PART);
        for (int rbase = bid * 8 + wave; rbase < MP; rbase += G * 8 * 4) {
            f32x4 x[4][4]; int rows[4];
#pragma unroll
            for (int k = 0; k < 4; ++k) { const int row = rbase + k * G * 8; rows[k] = row;
                const float* src = nullptr;
                if (row < ROW_SAMPLE) src = p.x_prompt + (size_t)row * D;
                else if (row < ROW_META) src = p.x_sample + (size_t)(row - ROW_SAMPLE) * D;
                else if (row < ROW_PAD) src = p.meta + (size_t)((row - ROW_META) & 15) * D;
#pragma unroll
                for (int i = 0; i < 4; ++i) x[k][i] = src ? gld16f(src + i * 256 + lane * 4) : (f32x4){0.f, 0.f, 0.f, 0.f}; }
#pragma unroll
            for (int k = 0; k < 4; ++k) { const int row = rows[k]; if (row >= MP) continue;
                float ss = 0.f;
#pragma unroll
                for (int i = 0; i < 4; ++i) { const int c = i * 256 + lane * 4; const f32x4 v = x[k][i];
                    ss += (v[0] * v[0] + v[1] * v[1]) + (v[2] * v[2] + v[3] * v[3]);
                    u32x2 w; w.x = cvt_pk_bf16(v[0], v[1]); w.y = cvt_pk_bf16(v[2], v[3]); gst8u(hb + (size_t)row * D + c, w); }
#pragma unroll
                for (int o = 32; o >= 1; o >>= 1) ss += shx(ss, o, lane);
                if (lane < 16) part[(size_t)row * 16 + lane] = lane == 0 ? ss : 0.f;
            }
        }
    }
    {
        float* oml = (float*)(ws + WS_VEC); float* sp = oml + 1024;
        for (int i = bid * NTHR + tid; i < 1024; i += G * NTHR) {
            oml[i] = 1.0f / (1.0f + expf(p.a_lb[i] - p.a_lb[1024 + i]));
            const float l = -p.b_lambda[i]; sp[i] = l > 20.f ? l : log1pf(expf(l));
        }
        bf16_t* wg = (bf16_t*)(ws + W_G);
        for (int i = bid * NTHR + tid; i < 8 * 256 * 128; i += G * NTHR) {
            const int pn = i >> 15, nrow = (i >> 7) & 255, kk = i & 127;
            const float* w = nrow < 128 ? p.b_wa : p.b_wx; const float v = w[((size_t)pn * 128 + kk) * 128 + (nrow & 127)];
            wg[i] = (bf16_t)(cvt_pk_bf16(v, 0.f) & 0xffffu);
        }
    }
    for (int w = bid; w < 1312; w += G) {
        int t = w;
        if (t < 704) { const int i = t / 176; t -= i * 176; convert_tile(p.ffn_w_in + (size_t)i * D * 2 * DFF, 2 * DFF, D, p.ffn_norm + (size_t)i * D, (bf16_t*)(ws + W_FFN_IN + i * SZ_FFN_IN), 1, t, tid); continue; }
        t -= 704;
        if (t < 352) { const int i = t / 88; t -= i * 88; convert_tile(p.ffn_w_out + (size_t)i * DFF * D, D, DFF, nullptr, (bf16_t*)(ws + W_FFN_OUT + i * SZ_FFN_OUT), 0, t, tid); continue; }
        t -= 352;
        if (t < 128) { convert_tile(p.a_w_in, 4096, D, p.mix_norm, (bf16_t*)(ws + W_A_IN), 0, t, tid); continue; }
        t -= 128;
        if (t < 32) { convert_tile(p.a_w_out, D, D, nullptr, (bf16_t*)(ws + W_A_OUT), 0, t, tid); continue; }
        t -= 32;
        if (t < 64) { convert_tile(p.b_w_in, 2048, D, p.mix_norm + D, (bf16_t*)(ws + W_B_IN), 0, t, tid); continue; }
        t -= 64;
        convert_tile(p.b_w_out, D, D, nullptr, (bf16_t*)(ws + W_B_OUT), 0, t, tid);
    }
}

typedef short bf16x4 __attribute__((ext_vector_type(4)));
template <int CTRL> __device__ __forceinline__ float dpp_f(float x) { return __int_as_float(__builtin_amdgcn_update_dpp(0, __float_as_int(x), CTRL, 0xf, 0xf, true)); }
__device__ __forceinline__ float bperm(int srclane, float v) { return __int_as_float(__builtin_amdgcn_ds_bpermute(srclane << 2, __float_as_int(v))); }
constexpr int GL_QD = 0, GL_KD = 4352, GL_KKT = 8704, GL_VT = 13824, GL_DEC = 18944, GL_RED = 19456, GL_BUF = 19712, GL_GRP = 2 * GL_BUF;

#define GAS __attribute__((address_space(1)))
__device__ __forceinline__ u32x4 gld16(const bf16_t* p) { return *(const GAS u32x4*)(const GAS void*)p; }
__device__ __forceinline__ u32x2 gld8(const bf16_t* p) { return *(const GAS u32x2*)(const GAS void*)p; }
__device__ __forceinline__ void gst8(bf16_t* p, u32x2 v) { *(GAS u32x2*)(GAS void*)p = v; }
template <bool OUT>
__device__ __forceinline__ void gla_mfma(LAS unsigned char* lds, const bf16_t* Qb, const bf16_t* Kb, const bf16_t* Vb, const bf16_t* Gb, bf16_t* Yb, int row0, int nblk, int h,
                                         const float* Sin, float* Sout, float* Dout, const float* onorm, int tid, bool tin, bool tout) {
    const int g = tid >> 8, gt = tid & 255, w = gt >> 6, lane = tid & 63, fr = lane & 15, quad = lane >> 4, g8 = gt >> 4;
    LAS unsigned char* L0 = lds + g * GL_GRP;
    f32x4 S[8][2];
    {
        if (tin) {
            int tb = (w * 64 + lane) * 4; asm volatile("" : "+v"(tb)); const GAS f32x4* sp4 = (const GAS f32x4*)(const GAS void*)(Sin + tb);
#pragma unroll
            for (int m = 0; m < 8; ++m)
#pragma unroll
                for (int n = 0; n < 2; ++n) S[m][n] = sp4[(m * 2 + n) * 256];
        } else {
        int sb = (4 * quad) * 128 + 32 * w + fr; asm volatile("" : "+v"(sb)); const GAS float* sp_ = (const GAS float*)(const GAS void*)(Sin + sb);
#pragma unroll
        for (int m = 0; m < 8; ++m)
#pragma unroll
            for (int n = 0; n < 2; ++n)
#pragma unroll
                for (int i = 0; i < 4; ++i) S[m][n][i] = sp_[(16 * m + i) * 128 + 16 * n];
        }
    }
    float bsum[8];
#pragma unroll
    for (int j = 0; j < 8; ++j) bsum[j] = 0.f;
    const size_t coff = (size_t)h * 128 + 8 * g8;
    u32x4 kw = gld16(Kb + (size_t)(row0 + fr) * D + coff), vw = gld16(Vb + (size_t)(row0 + fr) * D + coff), qw = kw;
    if (OUT) qw = gld16(Qb + (size_t)(row0 + fr) * D + coff);
    auto stage_a = [&](LAS unsigned char* L, const u32x4 kwv, const u32x4 qwv, const u32x4 vwv) {
        const unsigned kk_[4] = {kwv.x, kwv.y, kwv.z, kwv.w}, qq_[4] = {qwv.x, qwv.y, qwv.z, qwv.w}, vv_[4] = {vwv.x, vwv.y, vwv.z, vwv.w};
        float kf[8], bb[8], bl[8];
#pragma unroll
        for (int j = 0; j < 8; ++j) { kf[j] = (j & 1) ? bf_hi(kk_[j >> 1]) : bf_lo(kk_[j >> 1]);
            float x = __builtin_amdgcn_logf(1.0f - kf[j]);
            x += dpp_f<0x111>(x); x += dpp_f<0x112>(x); x += dpp_f<0x114>(x); x += dpp_f<0x118>(x);
            bb[j] = x; }
#pragma unroll
        for (int j = 0; j < 8; ++j) bl[j] = bperm(lane | 15, bb[j]);
        float qd[8], kd[8], kx[8];
#pragma unroll
        for (int j = 0; j < 8; ++j) { kx[j] = kf[j] * __builtin_amdgcn_exp2f(bl[j] - bb[j]);
            if (OUT) { const float q = (j & 1) ? bf_hi(qq_[j >> 1]) : bf_lo(qq_[j >> 1]); qd[j] = q * __builtin_amdgcn_exp2f(bb[j]); kd[j] = kf[j] * __builtin_amdgcn_exp2f(-bb[j]); } }
        if (OUT) {
            u32x4 wq, wk; wq.x = cvt_pk_bf16(qd[0], qd[1]); wq.y = cvt_pk_bf16(qd[2], qd[3]); wq.z = cvt_pk_bf16(qd[4], qd[5]); wq.w = cvt_pk_bf16(qd[6], qd[7]);
            wk.x = cvt_pk_bf16(kd[0], kd[1]); wk.y = cvt_pk_bf16(kd[2], kd[3]); wk.z = cvt_pk_bf16(kd[4], kd[5]); wk.w = cvt_pk_bf16(kd[6], kd[7]);
            *(LAS u32x4*)(L + GL_QD + fr * 272 + g8 * 16) = wq; *(LAS u32x4*)(L + GL_KD + fr * 272 + g8 * 16) = wk;
        }
#pragma unroll
        for (int j = 0; j < 8; j += 2) { const unsigned pk = cvt_pk_bf16(kx[j], kx[j + 1]);
            *(LAS unsigned short*)(L + GL_KKT + (8 * g8 + j) * 40 + fr * 2) = (unsigned short)(pk & 0xffffu);
            *(LAS unsigned short*)(L + GL_KKT + (8 * g8 + j + 1) * 40 + fr * 2) = (unsigned short)(pk >> 16);
            *(LAS unsigned short*)(L + GL_VT + (8 * g8 + j) * 40 + fr * 2) = (unsigned short)(vv_[j >> 1] & 0xffffu);
            *(LAS unsigned short*)(L + GL_VT + (8 * g8 + j + 1) * 40 + fr * 2) = (unsigned short)(vv_[j >> 1] >> 16); }
        if (fr == 0) { *(LAS f32x4*)(L + GL_DEC + g8 * 32) = (f32x4){__builtin_amdgcn_exp2f(bl[0]), __builtin_amdgcn_exp2f(bl[1]), __builtin_amdgcn_exp2f(bl[2]), __builtin_amdgcn_exp2f(bl[3])};
                       *(LAS f32x4*)(L + GL_DEC + g8 * 32 + 16) = (f32x4){__builtin_amdgcn_exp2f(bl[4]), __builtin_amdgcn_exp2f(bl[5]), __builtin_amdgcn_exp2f(bl[6]), __builtin_amdgcn_exp2f(bl[7])}; }
        if (!OUT) {
#pragma unroll
            for (int j = 0; j < 8; ++j) bsum[j] += bl[j];
        }
    };
    stage_a(L0, kw, qw, vw);
    if (nblk > 1) { const size_t o = (size_t)(row0 + 16 + fr) * D + coff; kw = gld16(Kb + o); vw = gld16(Vb + o); if (OUT) qw = gld16(Qb + o); }
    __syncthreads();
    for (int blk = 0; blk < nblk; ++blk) {
        const int rb = row0 + blk * 16;
        LAS unsigned char* L = L0 + (blk & 1) * GL_BUF;
        bf16x4 vfr[2];
#pragma unroll
        for (int n = 0; n < 2; ++n) vfr[n] = *(const LAS bf16x4*)(L + GL_VT + (32 * w + 16 * n + fr) * 40 + quad * 8);
        f32x4 o[2];
        if (OUT) {
            bf16x8 qf[4];
            f32x4 sc = (f32x4){0.f, 0.f, 0.f, 0.f};
#pragma unroll
            for (int kb = 0; kb < 4; ++kb) {
                const bf16x4 q0 = *(const LAS bf16x4*)(L + GL_QD + fr * 272 + (32 * kb + 4 * quad) * 2), q1 = *(const LAS bf16x4*)(L + GL_QD + fr * 272 + (32 * kb + 16 + 4 * quad) * 2);
                const bf16x4 k0 = *(const LAS bf16x4*)(L + GL_KD + fr * 272 + (32 * kb + 4 * quad) * 2), k1 = *(const LAS bf16x4*)(L + GL_KD + fr * 272 + (32 * kb + 16 + 4 * quad) * 2);
                qf[kb] = (bf16x8){q0[0], q0[1], q0[2], q0[3], q1[0], q1[1], q1[2], q1[3]};
                const bf16x8 kfv = (bf16x8){k0[0], k0[1], k0[2], k0[3], k1[0], k1[1], k1[2], k1[3]};
                sc = __builtin_amdgcn_mfma_f32_16x16x32_bf16(kfv, qf[kb], sc, 0, 0, 0);
            }
#pragma unroll
            for (int i = 0; i < 4; ++i) sc[i] = (4 * quad + i <= fr) ? sc[i] : 0.f;
            bf16x4 P; { const unsigned p0 = cvt_pk_bf16(sc[0], sc[1]), p1 = cvt_pk_bf16(sc[2], sc[3]); P = (bf16x4){(short)(p0 & 0xffffu), (short)(p0 >> 16), (short)(p1 & 0xffffu), (short)(p1 >> 16)}; }
#pragma unroll
            for (int n = 0; n < 2; ++n) {
                o[n] = (f32x4){0.f, 0.f, 0.f, 0.f};
#pragma unroll
                for (int kb = 0; kb < 4; ++kb) {
                    const unsigned a0 = cvt_pk_bf16(S[2 * kb][n][0], S[2 * kb][n][1]), a1 = cvt_pk_bf16(S[2 * kb][n][2], S[2 * kb][n][3]);
                    const unsigned a2 = cvt_pk_bf16(S[2 * kb + 1][n][0], S[2 * kb + 1][n][1]), a3 = cvt_pk_bf16(S[2 * kb + 1][n][2], S[2 * kb + 1][n][3]);
                    const bf16x8 sa = (bf16x8){(short)(a0 & 0xffffu), (short)(a0 >> 16), (short)(a1 & 0xffffu), (short)(a1 >> 16), (short)(a2 & 0xffffu), (short)(a2 >> 16), (short)(a3 & 0xffffu), (short)(a3 >> 16)};
                    o[n] = __builtin_amdgcn_mfma_f32_16x16x32_bf16(sa, qf[kb], o[n], 0, 0, 0);
                }
                asm volatile("s_nop 7\n\ts_nop 3" : "+v"(o[n]));
                o[n] = __builtin_amdgcn_mfma_f32_16x16x16bf16_1k(vfr[n], P, o[n], 0, 0, 0);
            }
            asm volatile("s_nop 7\n\ts_nop 7" : "+v"(o[0]), "+v"(o[1]));
        }
#pragma unroll
        for (int m = 0; m < 8; ++m) {
            const bf16x4 kkf = *(const LAS bf16x4*)(L + GL_KKT + (16 * m + fr) * 40 + quad * 8);
            const f32x4 dec = *(const LAS f32x4*)(L + GL_DEC + (16 * m + 4 * quad) * 4);
#pragma unroll
            for (int n = 0; n < 2; ++n) S[m][n] = __builtin_amdgcn_mfma_f32_16x16x16bf16_1k(kkf, vfr[n], S[m][n] * dec, 0, 0, 0);
        }
        if (blk + 1 < nblk) {
            stage_a(L0 + ((blk + 1) & 1) * GL_BUF, kw, qw, vw);
            if (blk + 2 < nblk) { const size_t o2 = (size_t)(rb + 32 + fr) * D + coff; kw = gld16(Kb + o2); vw = gld16(Vb + o2); if (OUT) qw = gld16(Qb + o2); }
        }
        if (!OUT) __syncthreads();
        if (OUT) {
            float ss = 0.f;
#pragma unroll
            for (int n = 0; n < 2; ++n) ss += (o[n][0] * o[n][0] + o[n][1] * o[n][1]) + (o[n][2] * o[n][2] + o[n][3] * o[n][3]);
            ss += shx(ss, 16, lane); ss += shx(ss, 32, lane);
            if (quad == 0) *(LAS float*)(L + GL_RED + (w * 16 + fr) * 4) = ss;
            const size_t yoff = (size_t)(rb + fr) * D + h * 128 + 32 * w + 4 * quad;
            const u32x2 g0 = gld8(Gb + yoff), g1 = gld8(Gb + yoff + 16);
            const f32x4 n0 = *(const f32x4*)(onorm + h * 128 + 32 * w + 4 * quad), n1 = *(const f32x4*)(onorm + h * 128 + 32 * w + 16 + 4 * quad);
            __syncthreads();
            const float tot = (*(const LAS float*)(L + GL_RED + fr * 4) + *(const LAS float*)(L + GL_RED + (16 + fr) * 4)) + (*(const LAS float*)(L + GL_RED + (32 + fr) * 4) + *(const LAS float*)(L + GL_RED + (48 + fr) * 4));
            const float rs = rsqrtf(tot * (1.0f / 128.0f) + EPS);
            u32x2 y0, y1;
            y0.x = cvt_pk_bf16(o[0][0] * rs * n0[0] * bf_lo(g0.x), o[0][1] * rs * n0[1] * bf_hi(g0.x)); y0.y = cvt_pk_bf16(o[0][2] * rs * n0[2] * bf_lo(g0.y), o[0][3] * rs * n0[3] * bf_hi(g0.y));
            y1.x = cvt_pk_bf16(o[1][0] * rs * n1[0] * bf_lo(g1.x), o[1][1] * rs * n1[1] * bf_hi(g1.x)); y1.y = cvt_pk_bf16(o[1][2] * rs * n1[2] * bf_lo(g1.y), o[1][3] * rs * n1[3] * bf_hi(g1.y));
            gst8(Yb + yoff, y0); gst8(Yb + yoff + 16, y1);
        }
    }
    asm volatile("s_nop 7\n\ts_nop 7" : "+v"(S[7][0]), "+v"(S[7][1]), "+v"(S[6][0]), "+v"(S[6][1]));
    if (Sout && tout) {
        int tb = (w * 64 + lane) * 4; asm volatile("" : "+v"(tb)); GAS f32x4* sp4 = (GAS f32x4*)(GAS void*)(Sout + tb);
#pragma unroll
        for (int m = 0; m < 8; ++m)
#pragma unroll
            for (int n = 0; n < 2; ++n) sp4[(m * 2 + n) * 256] = S[m][n];
    }
    if (Sout && !tout) {
        int sb = (4 * quad) * 128 + 32 * w + fr; asm volatile("" : "+v"(sb)); float* sp_ = Sout + sb;
#pragma unroll
        for (int m = 0; m < 8; ++m)
#pragma unroll
            for (int n = 0; n < 2; ++n)
#pragma unroll
                for (int i = 0; i < 4; ++i) sp_[(16 * m + i) * 128 + 16 * n] = S[m][n][i];
    }
    if (!OUT && Dout && fr == 0) {
#pragma unroll
        for (int j = 0; j < 8; ++j) Dout[8 * g8 + j] = __builtin_amdgcn_exp2f(bsum[j]);
    }
}

__device__ __forceinline__ void gla_chunk_rows(int seq, int c, int& row0, int& nblk) { if (c == 0) { row0 = ROW_META + 16 * seq; nblk = 1; } else { row0 = 8192 * seq + 256 * (c - 1); nblk = 16; } }

__device__ __forceinline__ void phase_gla1(LAS unsigned char* lds) { Params p; LOADP(ws);
    unsigned char* ws = p.ws; float* SST = (float*)(ws + SC_SST); float* DC = (float*)(ws + SC_DC);
    const int tid = otid();
    for (int pi = obid(); pi < 512; pi += gridDim.x) {
        const int i = 2 * pi + (tid >> 8); int seq, h, c;
        if (i < 992) { seq = i / 248; const int r = i - seq * 248; h = r / 31; c = 1 + (r - h * 31); } else { seq = (i - 992) >> 3; h = (i - 992) & 7; c = 0; }
        int row0, nblk; gla_chunk_rows(seq, c, row0, nblk);
        const size_t sh = (size_t)(seq * 8 + h) * NCH;
        gla_mfma<false>(lds, nullptr, (const bf16_t*)(ws + SC_K), (const bf16_t*)(ws + SC_V), nullptr, nullptr, row0, nblk, h, (const float*)(ws + WS_ZERO), SST + (sh + c + 1) * 16384, DC + (sh + c) * 128, nullptr, tid, true, true);
        __syncthreads();
    }
}
__device__ __forceinline__ void phase_gla2() { Params p; LOADP(ws);
    unsigned char* ws = p.ws; float* SST = (float*)(ws + SC_SST); const float* DC = (const float*)(ws + SC_DC);
    for (int idx = obid() * NTHR + otid(); idx < 32 * 4096; idx += gridDim.x * NTHR) {
        const int sh = idx >> 12, e4 = idx & 4095, m = e4 >> 9, quad = (e4 >> 4) & 3, dk0 = 16 * m + 4 * quad;
        float* base = SST + (size_t)sh * NCH * 16384 + e4 * 4; const float* dcb = DC + (size_t)sh * NCH * 128 + dk0;
        f32x4 v[32];
#pragma unroll
        for (int c = 0; c < 32; ++c) v[c] = *(const f32x4*)(base + (size_t)(c + 1) * 16384);
#pragma unroll
        for (int cb = 0; cb < 4; ++cb) {
            f32x4 dv[8];
#pragma unroll
            for (int j = 0; j < 8; ++j) dv[j] = *(const f32x4*)(dcb + (size_t)(cb * 8 + j) * 128);
#pragma unroll
            for (int j = 0; j < 8; ++j) { const int c = cb * 8 + j; if (c >= 1) { v[c] += v[c - 1] * dv[j]; *(f32x4*)(base + (size_t)(c + 1) * 16384) = v[c]; } }
        }
    }
}
__device__ __forceinline__ void phase_gla3(LAS unsigned char* lds) { Params p; LOADP(ws); LOADP(out); LOADP(state_hgrn); LOADP(a_onorm);
    unsigned char* ws = p.ws; float* SST = (float*)(ws + SC_SST);
    const bf16_t *Qb = (const bf16_t*)(ws + SC_Q), *Kb = (const bf16_t*)(ws + SC_K), *Vb = (const bf16_t*)(ws + SC_V), *Gb = (const bf16_t*)(ws + SC_G); bf16_t* Yb = (bf16_t*)(ws + SC_G);
    const int tid = otid();
    for (int pi = obid(); pi < 592; pi += gridDim.x) {
        const int i = 2 * pi + (tid >> 8);
        int row0, nblk, h; const float* Sin = (const float*)(ws + WS_ZERO); float* Sout = nullptr;
        if (i < 1056) {
            int seq, c; if (i < 1024) { seq = i >> 8; h = (i >> 5) & 7; c = 1 + (i & 31); } else { seq = (i - 1024) >> 3; h = (i - 1024) & 7; c = 0; }
            gla_chunk_rows(seq, c, row0, nblk);
            if (c > 0) Sin = SST + ((size_t)(seq * 8 + h) * NCH + c) * 16384;
            if (c == 32) Sout = p.out + O_HP + (size_t)(seq * 8 + h) * 16384;
        } else {
            const int j = i - 1056, sidx = j >> 3; h = j & 7; row0 = ROW_SAMPLE + 16 * sidx; nblk = 1;
            Sin = p.state_hgrn + (size_t)(sidx * 8 + h) * 16384; Sout = p.out + O_HS + (size_t)(sidx * 8 + h) * 16384;
        }
        gla_mfma<true>(lds, Qb, Kb, Vb, Gb, Yb, row0, nblk, h, Sin, Sout, nullptr, p.a_onorm, tid, pi < 512, false);
        __syncthreads();
    }
}

__device__ __forceinline__ void unpack8(const u32x4 w, float (&x)[8]) { x[0] = bf_lo(w.x); x[1] = bf_hi(w.x); x[2] = bf_lo(w.y); x[3] = bf_hi(w.y); x[4] = bf_lo(w.z); x[5] = bf_hi(w.z); x[6] = bf_lo(w.w); x[7] = bf_hi(w.w); }
__device__ __forceinline__ void phase_conv() { Params p; LOADP(ws); LOADP(b_conv_b); LOADP(b_conv_w); LOADP(state_conv);
    unsigned char* ws = p.ws; const bf16_t* XB = (const bf16_t*)(ws + SC_XB); bf16_t* CF = (bf16_t*)(ws + SC_CF);
    const int tid = otid(), lane = tid & 63, wave = tid >> 6;
    for (int g = obid() * 8 + wave; g < MP / 16; g += gridDim.x * 8) {
        const int r0 = g * 16;
#pragma unroll
        for (int half = 0; half < 2; ++half) {
            const int c = half * 512 + lane * 8;
            if (r0 >= ROW_PAD) {
#pragma unroll
                for (int t = 0; t < 16; ++t) gst16(CF + (size_t)(r0 + t) * D + c, (u32x4){0u, 0u, 0u, 0u});
                continue;
            }
            u32x4 xw[16];
#pragma unroll
            for (int t = 0; t < 16; ++t) xw[t] = gld16(XB + (size_t)(r0 + t) * D + c);
            float hx[3][8];
            if (r0 < ROW_SAMPLE) {
                const int hb0 = (r0 & 8191) == 0 ? ROW_META + 16 * (r0 >> 13) + 13 : r0 - 3;
#pragma unroll
                for (int j = 0; j < 3; ++j) unpack8(gld16(XB + (size_t)(hb0 + j) * D + c), hx[j]);
            } else if (r0 < ROW_META) {
                const float* sc_ = p.state_conv + (size_t)((r0 - ROW_SAMPLE) >> 4) * 3 * D + c;
#pragma unroll
                for (int j = 0; j < 3; ++j) { const f32x4 a = *(const f32x4*)(sc_ + (size_t)j * D), b2 = *(const f32x4*)(sc_ + (size_t)j * D + 4);
#pragma unroll
                    for (int e = 0; e < 4; ++e) { hx[j][e] = a[e]; hx[j][4 + e] = b2[e]; } }
            } else {
#pragma unroll
                for (int j = 0; j < 3; ++j)
#pragma unroll
                    for (int e = 0; e < 8; ++e) hx[j][e] = 0.f;
            }
            float wv[4][8], bv[8];
#pragma unroll
            for (int j = 0; j < 4; ++j) { const f32x4 a = *(const f32x4*)(p.b_conv_w + (size_t)j * D + c), b2 = *(const f32x4*)(p.b_conv_w + (size_t)j * D + c + 4);
#pragma unroll
                for (int e = 0; e < 4; ++e) { wv[j][e] = a[e]; wv[j][4 + e] = b2[e]; } }
            { const f32x4 a = *(const f32x4*)(p.b_conv_b + c), b2 = *(const f32x4*)(p.b_conv_b + c + 4);
#pragma unroll
              for (int e = 0; e < 4; ++e) { bv[e] = a[e]; bv[4 + e] = b2[e]; } }
#pragma unroll
            for (int t = 0; t < 16; ++t) {
                float x[8], o[8]; unpack8(xw[t], x);
#pragma unroll
                for (int e = 0; e < 8; ++e) { o[e] = fmaf(x[e], wv[3][e], fmaf(hx[2][e], wv[2][e], fmaf(hx[1][e], wv[1][e], fmaf(hx[0][e], wv[0][e], bv[e]))));
                    hx[0][e] = hx[1][e]; hx[1][e] = hx[2][e]; hx[2][e] = x[e]; }
                u32x4 w; w.x = cvt_pk_bf16(o[0], o[1]); w.y = cvt_pk_bf16(o[2], o[3]); w.z = cvt_pk_bf16(o[4], o[5]); w.w = cvt_pk_bf16(o[6], o[7]);
                gst16(CF + (size_t)(r0 + t) * D + c, w);
            }
        }
    }
}
__device__ __forceinline__ void rg_chunk_rows(int seq, int c, int& row0, int& ntok) { if (c == 0) { row0 = ROW_META + 16 * seq; ntok = 16; } else { row0 = 8192 * seq + 64 * (c - 1); ntok = 64; } }
__device__ __forceinline__ void phase_scan1() { Params p; LOADP(ws);
    unsigned char* ws = p.ws; const bf16_t* OM = (const bf16_t*)(ws + SC_OM); const bf16_t* UU = (const bf16_t*)(ws + SC_UU); f32x4* AB = (f32x4*)(ws + SC_AB);
    const int tid = otid(), sub = tid >> 8, tt = tid & 255;
    for (int i = 2 * obid() + sub; i < 4 * (RCH - 1); i += 2 * gridDim.x) {
        const int seq = i / (RCH - 1), c = i % (RCH - 1);
        int row0, ntok; rg_chunk_rows(seq, c, row0, ntok);
        float a[4] = {1.f, 1.f, 1.f, 1.f}, h[4] = {0.f, 0.f, 0.f, 0.f};
#pragma unroll 16
        for (int t = 0; t < ntok; ++t) { const size_t o = (size_t)(row0 + t) * D + 4 * tt; const u32x2 om = gld8(OM + o), uu = gld8(UU + o);
            const float x0 = 1.0f - bf_lo(om.x), x1 = 1.0f - bf_hi(om.x), x2 = 1.0f - bf_lo(om.y), x3 = 1.0f - bf_hi(om.y);
            h[0] = fmaf(x0, h[0], bf_lo(uu.x)); h[1] = fmaf(x1, h[1], bf_hi(uu.x)); h[2] = fmaf(x2, h[2], bf_lo(uu.y)); h[3] = fmaf(x3, h[3], bf_hi(uu.y));
            a[0] *= x0; a[1] *= x1; a[2] *= x2; a[3] *= x3; }
        f32x4* ab = AB + (size_t)(seq * RCH + c) * 512 + 2 * tt;
        ab[0] = (f32x4){a[0], h[0], a[1], h[1]}; ab[1] = (f32x4){a[2], h[2], a[3], h[3]};
    }
}
__device__ __forceinline__ void phase_scan3() { Params p; LOADP(ws); LOADP(out); LOADP(state_rglru);
    unsigned char* ws = p.ws; const bf16_t* OM = (const bf16_t*)(ws + SC_OM); const bf16_t* UU = (const bf16_t*)(ws + SC_UU); const f32x4* AB = (const f32x4*)(ws + SC_AB);
    bf16_t* GY = (bf16_t*)(ws + SC_GG);
    const int tid = otid(), sub = tid >> 8, tt = tid & 255;
    for (int i = 2 * obid() + sub; i < 4 * RCH + 16; i += 2 * gridDim.x) {
        int row0, ntok; float h[4] = {0.f, 0.f, 0.f, 0.f}; float* hout = nullptr;
        if (i < 4 * RCH) {
            int seq, c; if (i < 512) { seq = i & 3; c = 128 - (i >> 2); } else { seq = i - 512; c = 0; }
            rg_chunk_rows(seq, c, row0, ntok);
#pragma unroll 16
            for (int j = 0; j < c; ++j) { const f32x4* ab = AB + (size_t)(seq * RCH + j) * 512 + 2 * tt; const f32x4 p0 = ab[0], p1 = ab[1];
                h[0] = fmaf(p0[0], h[0], p0[1]); h[1] = fmaf(p0[2], h[1], p0[3]); h[2] = fmaf(p1[0], h[2], p1[1]); h[3] = fmaf(p1[2], h[3], p1[3]); }
            if (c == RCH - 1) hout = p.out + O_RP + (size_t)seq * D;
        } else {
            const int s_ = i - 4 * RCH; row0 = ROW_SAMPLE + 16 * s_; ntok = 16;
            const f32x4 hh = *(const f32x4*)(p.state_rglru + (size_t)s_ * D + 4 * tt); h[0] = hh[0]; h[1] = hh[1]; h[2] = hh[2]; h[3] = hh[3]; hout = p.out + O_RS + (size_t)s_ * D;
        }
        for (int t0 = 0; t0 < ntok; t0 += 16) {
            u32x2 om[16], uu[16], gg[16];
#pragma unroll
            for (int t = 0; t < 16; ++t) { const size_t o = (size_t)(row0 + t0 + t) * D + 4 * tt; om[t] = gld8(OM + o); uu[t] = gld8(UU + o); gg[t] = gld8(GY + o); }
#pragma unroll
            for (int t = 0; t < 16; ++t) {
                {
                    f32x2 ha = {h[0], h[1]}, hb2 = {h[2], h[3]};
                    const f32x2 oa = {bf_lo(om[t].x), bf_hi(om[t].x)}, ob = {bf_lo(om[t].y), bf_hi(om[t].y)}, ua = {bf_lo(uu[t].x), bf_hi(uu[t].x)}, ub = {bf_lo(uu[t].y), bf_hi(uu[t].y)};
                    ha = (1.0f - oa) * ha + ua; hb2 = (1.0f - ob) * hb2 + ub; h[0] = ha.x; h[1] = ha.y; h[2] = hb2.x; h[3] = hb2.y; }
                const f32x2 ga = {bf_lo(gg[t].x), bf_hi(gg[t].x)}, gb2 = {bf_lo(gg[t].y), bf_hi(gg[t].y)}; const f32x2 ya = (f32x2){h[0], h[1]} * ga, yb = (f32x2){h[2], h[3]} * gb2;
                u32x2 y; y.x = cvt_pk_bf16(ya.x, ya.y); y.y = cvt_pk_bf16(yb.x, yb.y);
                gst8(GY + (size_t)(row0 + t0 + t) * D + 4 * tt, y); }
        }
        if (hout) *(f32x4*)(hout + 4 * tt) = (f32x4){h[0], h[1], h[2], h[3]};
    }
}
__device__ __forceinline__ void phase_final(const float* part) { Params p; LOADP(out); LOADP(final_norm);
    const int tid = otid(), lane = tid & 63, wave = tid >> 6;
    f32x4 gn[4];
#pragma unroll
    for (int i = 0; i < 4; ++i) gn[i] = *(const f32x4*)(p.final_norm + i * 256 + lane * 4);
    const int G8 = gridDim.x * 8;
    for (int rbase = obid() * 8 + wave; rbase < ROW_META; rbase += G8 * 4) {
        f32x4 x[4][4]; float sv[4];
#pragma unroll
        for (int k = 0; k < 4; ++k) { const int row = rbase + k * G8; const bool ok = row < ROW_META; const int rr = ok ? row : 0;
            sv[k] = lane < 16 ? part[(size_t)rr * 16 + lane] : 0.f;
#pragma unroll
            for (int i = 0; i < 4; ++i) x[k][i] = gld16f(p.out + (size_t)rr * D + i * 256 + lane * 4); }
#pragma unroll
        for (int k = 0; k < 4; ++k) { const int row = rbase + k * G8; if (row >= ROW_META) continue;
            float s_ = sv[k];
#pragma unroll
            for (int o = 8; o >= 1; o >>= 1) s_ += shx(s_, o, lane);
            s_ = __int_as_float(__builtin_amdgcn_readfirstlane(__float_as_int(s_)));
            const float rs = rsqrtf(s_ * (1.0f / 1024.0f) + EPS); float* hp = p.out + (size_t)row * D;
#pragma unroll
            for (int i = 0; i < 4; ++i) gst16f(hp + i * 256 + lane * 4, x[k][i] * rs * gn[i]); }
    }
}


#define XB_TMO      128
#define XB_XCNT(j)  (256  + 64 * (j))
#define XB_XSUB(j)  (1280 + 64 * (j))
#define XB_XGEN(j)  (2304 + 64 * (j))
#define XB_TOP      3328
#define XB_TOPGEN   3392
#define XCD_BAR_WORDS 3456
#define XB_SPIN_CAP (1u << 18)
__device__ __forceinline__ unsigned xb_ld(unsigned* p)              { return __hip_atomic_load(p, __ATOMIC_RELAXED, __HIP_MEMORY_SCOPE_AGENT); }
__device__ __forceinline__ unsigned xb_add(unsigned* p, unsigned v) { return __hip_atomic_fetch_add(p, v, __ATOMIC_RELAXED, __HIP_MEMORY_SCOPE_AGENT); }
__device__ __forceinline__ unsigned xb_xcc_id() { return (unsigned)__builtin_amdgcn_s_getreg((3 << 11) | 20) & 0xFu; }
#define XB_SPIN(cond, bar) do { unsigned _sp = 0; while (cond) { __builtin_amdgcn_s_sleep(1); \
    if ((++_sp & 255u) == 0u) { if (xb_ld(&(bar)[XB_TMO])) break; if (_sp > XB_SPIN_CAP) { atomicAdd(&(bar)[XB_TMO], 1u); break; } } } } while (0)
struct XcdBarrier { unsigned* bar; unsigned x; volatile LAS unsigned* st; };
__device__ __forceinline__ XcdBarrier xcd_barrier_post(unsigned* bar, volatile LAS unsigned* st) {
    XcdBarrier b; b.bar = bar; b.x = xb_xcc_id(); b.st = st;
    if (threadIdx.x == 0) (void)xb_add(&bar[XB_XCNT(b.x)], 1u);
    return b;
}
__device__ __forceinline__ void xcd_barrier_complete(unsigned* bar, unsigned x, unsigned& nloc, unsigned& nx) {
    const unsigned G = gridDim.x * gridDim.y * gridDim.z;
    unsigned sum, cnt, mine, sp = 0u;
    for (;;) {
        sum = 0u; cnt = 0u; mine = 0u;
#pragma unroll
        for (unsigned j = 0; j < 16; ++j) { const unsigned c = xb_ld(&bar[XB_XCNT(j)]); sum += c; cnt += (c > 0u) ? 1u : 0u; mine = (j == x) ? c : mine; }
        if (sum == G) break;
        __builtin_amdgcn_s_sleep(1);
        if ((++sp & 255u) == 0u) { if (xb_ld(&bar[XB_TMO])) break; if (sp > XB_SPIN_CAP) { atomicAdd(&bar[XB_TMO], 1u); break; } }
    }
    nloc = mine > 0u ? mine : 1u; nx = cnt > 0u ? cnt : 1u;
}
__device__ __forceinline__ void xcd_barrier(const XcdBarrier& b) {
    asm volatile("s_waitcnt vmcnt(0)" ::: "memory");
    __syncthreads();
    if (threadIdx.x == 0) {
        unsigned* bar = b.bar;
        __builtin_amdgcn_s_waitcnt(0);
        unsigned nloc = b.st[0], nx = b.st[1];
        if (nloc == 0u) { xcd_barrier_complete(bar, b.x, nloc, nx); b.st[0] = nloc; b.st[1] = nx; }
        const unsigned old = xb_add(&bar[XB_XSUB(b.x)], 1u);
        const unsigned gen = old / nloc;
        if (old + 1u == (gen + 1u) * nloc) {
            __builtin_amdgcn_fence(__ATOMIC_RELEASE, "agent");
            asm volatile("s_waitcnt vmcnt(0)" ::: "memory");
            const unsigned og = xb_add(&bar[XB_TOP], 1u);
            const unsigned tg = og / nx;
            if (og + 1u == (tg + 1u) * nx) xb_add(&bar[XB_TOPGEN], 1u);
            else XB_SPIN(xb_ld(&bar[XB_TOPGEN]) == tg, bar);
            __builtin_amdgcn_fence(__ATOMIC_ACQUIRE, "agent");
            xb_add(&bar[XB_XGEN(b.x)], 1u);
            asm volatile("s_waitcnt vmcnt(0)" ::: "memory");
        } else {
            XB_SPIN(xb_ld(&bar[XB_XGEN(b.x)]) == gen, bar);
            __builtin_amdgcn_fence(__ATOMIC_ACQUIRE, "agent");
            asm volatile("s_waitcnt vmcnt(0)" ::: "memory");
        }
    }
    __syncthreads();
}

#ifndef PHASE_SEQ
#define PHASE_SEQ 0, 1, 2, 3, 4, 5, 6, 7, 8, 9, 10, 11, 12, 13, 14, 15, 16, 17, 18, 19, 20
#endif
constexpr int SEQ_HOST[] = {PHASE_SEQ};
constexpr int NPHASE = sizeof(SEQ_HOST) / sizeof(int);
__device__ __forceinline__ int SEQ_AT(int si) { constexpr int t[] = {PHASE_SEQ}; int r = t[0];
#pragma unroll
    for (int i = 1; i < NPHASE; ++i) r = (si == i) ? t[i] : r;
    return r; }
__global__ void __launch_bounds__(NTHR, 2) fwd_kernel(Params p) {
    extern __shared__ __attribute__((aligned(16))) unsigned char shm[];
    LAS unsigned char* lds = (LAS unsigned char*)shm;
    cg::grid_group grid = cg::this_grid();
    __shared__ uint4 xb_words;
    if (threadIdx.x == 0) xb_words = make_uint4(0u, 0u, 0u, 0u);
    __syncthreads();
    XcdBarrier xbar = xcd_barrier_post((unsigned*)(LP(ws) + WS_BAR), (volatile LAS unsigned*)&xb_words);
    const int lo = p.ph_lo, hi = p.ph_hi, G = gridDim.x;
    enum { K_PREP, K_FFN_IN, K_RES, K_HGRN_IN, K_GLA1, K_GLA2, K_GLA3, K_RG_IN, K_CONV, K_GATE, K_SCAN1, K_SCAN3, K_FINAL };
    for (int si = lo; si < hi; ++si) {
        if (si > lo) { if (si == lo + 1) grid.sync(); else xcd_barrier(xbar); }
        int ph = SEQ_AT(si); const bool dup = ph >= 100; if (dup) ph -= 100;
        unsigned char* ws = LP(ws); float* outp = LP(out);
        float* part0 = (float*)(ws + WS_PART); float* part1 = (float*)(ws + WS_PART + SZ_PART);
        float* htail = (float*)(ws + WS_HTAIL); bf16_t* hb = (bf16_t*)(ws + WS_HB);
        const float* oml = (const float*)(ws + WS_VEC); const float* sp = oml + 1024;
        int kind = K_PREP, widx = 0, KK = D; float* pin = part0; float* pout = part1; const bf16_t* Ap = hb; const bf16_t* Wp = nullptr; float sc = 1.0f;
        switch (ph) {
            case 0: kind = K_PREP; break;
            case 1: kind = K_FFN_IN; widx = 0; pin = part0; break;
            case 2: kind = K_RES; Ap = (const bf16_t*)(ws + SC_U); Wp = (const bf16_t*)(ws + W_FFN_OUT + 0 * SZ_FFN_OUT); KK = DFF; pout = part1; sc = 0.5f; break;
            case 3: kind = K_HGRN_IN; pin = part1; break;
            case 4: kind = K_GLA1; break;
            case 5: kind = K_GLA2; break;
            case 6: kind = K_GLA3; break;
            case 7: kind = K_RES; Ap = (const bf16_t*)(ws + SC_G); Wp = (const bf16_t*)(ws + W_A_OUT); KK = D; pout = part0; sc = 1.0f; break;
            case 8: kind = K_FFN_IN; widx = 1; pin = part0; break;
            case 9: kind = K_RES; Ap = (const bf16_t*)(ws + SC_U); Wp = (const bf16_t*)(ws + W_FFN_OUT + 1 * SZ_FFN_OUT); KK = DFF; pout = part1; sc = 0.5f; break;
            case 10: kind = K_FFN_IN; widx = 2; pin = part1; break;
            case 11: kind = K_RES; Ap = (const bf16_t*)(ws + SC_U); Wp = (const bf16_t*)(ws + W_FFN_OUT + 2 * SZ_FFN_OUT); KK = DFF; pout = part0; sc = 0.5f; break;
            case 12: kind = K_RG_IN; pin = part0; break;
            case 13: kind = K_CONV; break;
            case 14: kind = K_GATE; break;
            case 15: kind = K_SCAN1; break;
            case 16: kind = K_SCAN3; break;
            case 17: kind = K_RES; Ap = (const bf16_t*)(ws + SC_GG); Wp = (const bf16_t*)(ws + W_B_OUT); KK = D; pout = part1; sc = 1.0f; break;
            case 18: kind = K_FFN_IN; widx = 3; pin = part1; break;
            case 19: kind = K_RES; Ap = (const bf16_t*)(ws + SC_U); Wp = (const bf16_t*)(ws + W_FFN_OUT + 3 * SZ_FFN_OUT); KK = DFF; pout = part0; sc = 0.5f; break;
            default: kind = K_FINAL; pin = part0; break;
        }
        if (kind == K_PREP) phase_prep(lds);
        else if (kind == K_FFN_IN || kind == K_RES) {
            const bool fold = (G == 256);
            const int cb = obid();
            bool tail_unit = false;
            if (kind == K_FFN_IN) {
                unsigned* tcnt = (unsigned*)(ws + WS_BAR) + 3584 + 128 * widx;
                pg8::Gemm g{hb, (const bf16_t*)(ws + W_FFN_IN + (size_t)widx * SZ_FFN_IN), D, D, D, MP / 256, 2 * DFF / 256}; pg8::StaticOrder S; S.init(g.nM, g.nN, G, cb); if (fold) S.mode = 1;
                EpiFfnIn E{(bf16_t*)(ws + SC_U), pin, fold ? tcnt : nullptr}; pg8::gemm_phase<EpiFfnIn, false>(lds, g, S, E);
                if (fold && cb >= 248) {
                    const int tpm = (cb - 248) >> 2;
                    if (otid() < 64) { unsigned spins = 0;
                        while ((unsigned)__builtin_amdgcn_readfirstlane(__hip_atomic_load(tcnt + 64 * tpm, __ATOMIC_RELAXED, __HIP_MEMORY_SCOPE_AGENT)) < 176u) { __builtin_amdgcn_s_sleep(4); if (++spins > (1u << 22)) break; }
                        __builtin_amdgcn_fence(__ATOMIC_ACQUIRE, "agent"); asm volatile("s_waitcnt vmcnt(0)" ::: "memory"); }
                    __syncthreads();
                    tail_unit = true; Ap = (const bf16_t*)(ws + SC_U); Wp = (const bf16_t*)(ws + W_FFN_OUT + (size_t)widx * SZ_FFN_OUT); KK = DFF; pout = (pin == part0) ? part1 : part0; sc = 0.5f;
                }
            }
            if (kind == K_RES || tail_unit) {
                const bool ffn_out = (KK == DFF);
                pg8::Gemm g{Ap, Wp, KK, KK, KK, (fold && ffn_out) ? 128 : MP / 256, D / 256}; pg8::StaticOrder S; S.init(g.nM, g.nN, G, cb);
                if (tail_unit) { S.mode = 2; S.spm = 128 + ((cb - 248) >> 2); S.spn = (cb - 248) & 3; }
                const int first_res = (!dup && (ph == 2 || (tail_unit && widx == 0))) ? 1 : 0;
                EpiRes E{outp, htail, hb, pout, dup ? 0.0f : sc, LP(x_prompt), LP(x_sample), LP(meta), first_res}; pg8::gemm_phase<EpiRes, false>(lds, g, S, E);
            }
        }
        else if (kind == K_HGRN_IN) { pg8::Gemm g{hb, (const bf16_t*)(ws + W_A_IN), D, D, D, MP / 256, 16}; pg8::StaticOrder S; S.init(g.nM, g.nN, G, obid());
            EpiHgrnIn E{(bf16_t*)(ws + SC_Q), (bf16_t*)(ws + SC_K), (bf16_t*)(ws + SC_V), (bf16_t*)(ws + SC_G), pin, oml}; pg8::gemm_phase<EpiHgrnIn, false>(lds, g, S, E); }
        else if (kind == K_GLA1) phase_gla1(lds);
        else if (kind == K_GLA2) phase_gla2();
        else if (kind == K_GLA3) phase_gla3(lds);
        else if (kind == K_RG_IN) { pg8::Gemm g{hb, (const bf16_t*)(ws + W_B_IN), D, D, D, MP / 256, 8}; pg8::StaticOrder S; S.init(g.nM, g.nN, G, obid());
            EpiRgIn E{(bf16_t*)(ws + SC_XB), (bf16_t*)(ws + SC_GG), pin, outp + O_CP, outp + O_CS}; pg8::gemm_phase<EpiRgIn, false>(lds, g, S, E); }
        else if (kind == K_CONV) phase_conv();
        else if (kind == K_GATE) { int kg = 128; asm volatile("" : "+s"(kg)); pg8::Gemm g{(const bf16_t*)(ws + SC_CF), (const bf16_t*)(ws + W_G), D, kg, kg, MP / 256, 8}; pg8::StaticOrder S; S.init(g.nM, g.nN, G, obid());
            EpiGate E{nullptr, (const bf16_t*)(ws + SC_CF), (bf16_t*)(ws + SC_OM), (bf16_t*)(ws + SC_UU), LP(b_ba), LP(b_bx), sp}; pg8::gemm_phase<EpiGate, true>(lds, g, S, E); }
        else if (kind == K_SCAN1) phase_scan1();
        else if (kind == K_SCAN3) phase_scan3();
        else phase_final(pin);
    }
}

extern "C" void kernel_launch(void* const* d_in, const int* in_sizes, int n_in, void* d_out, int out_size, void* d_ws, size_t ws_size, hipStream_t stream) {
    static int grid = 0;
    constexpr int LDS_BYTES = pg8::STAGE_BYTES + 16384;
    if (grid == 0) {
        if (n_in != 24 || ws_size < WS_TOTAL) { fprintf(stderr, "kernel_launch: unexpected n_in %d or workspace %zu < %zu\n", n_in, ws_size, (size_t)WS_TOTAL); grid = -1; return; }
        if (hipFuncSetAttribute((const void*)fwd_kernel, hipFuncAttributeMaxDynamicSharedMemorySize, LDS_BYTES) != hipSuccess) { fprintf(stderr, "kernel_launch: hipFuncSetAttribute failed\n"); grid = -1; return; }
        int dev = 0, cus = 0, per_cu = 0;
        hipGetDevice(&dev); hipDeviceGetAttribute(&cus, hipDeviceAttributeMultiprocessorCount, dev);
        hipOccupancyMaxActiveBlocksPerMultiprocessor(&per_cu, (const void*)fwd_kernel, NTHR, LDS_BYTES);
        if (per_cu < 1) { fprintf(stderr, "kernel_launch: occupancy query says %d blocks per CU\n", per_cu); per_cu = 1; }
        (void)hipGetLastError();
        grid = cus;
    }
    if (grid < 0) return;
    Params p{};
    const float** f = (const float**)&p;
    for (int i = 0; i < 24; ++i) f[i] = (const float*)d_in[i];
    p.out = (float*)d_out; p.ws = (unsigned char*)d_ws;
#if MK_FUSED
    if (hipMemsetAsync((char*)d_ws + WS_BAR, 0, 16384 + 65536, stream) != hipSuccess) { fprintf(stderr, "kernel_launch: hipMemsetAsync failed\n"); return; }
    p.ph_lo = 0; p.ph_hi = NPHASE;
    void* args[] = {&p};
    hipError_t e = hipLaunchCooperativeKernel((const void*)fwd_kernel, dim3(grid), dim3(NTHR), args, LDS_BYTES, stream);
    if (e != hipSuccess) fprintf(stderr, "cooperative launch failed: %s (grid %d)\n", hipGetErrorString(e), grid);
#else
    for (int k = 0; k < NPHASE; ++k) { p.ph_lo = k; p.ph_hi = k + 1; hipLaunchKernelGGL(fwd_kernel, dim3(grid), dim3(NTHR), LDS_BYTES, stream, p); }
#endif
}
```
